# Optimizing an MI355X kernel written in HIP

```python
import math
import jax, jax.numpy as jnp
from jax import lax
import numpy as np

D_MODEL = 2048
BATCH = 4
SEQ = 4096
DEPTH = 2

D_MIX = D_MODEL
A_HEADS = 8
A_HEAD_DIM = 128
A_WIDTH = A_HEADS * A_HEAD_DIM
KV_RANK = 256
IDX_HEADS = 16
IDX_DIM = 64
TOPK_MAX = 256
Q_BLOCK = 128
REL_BUCKETS = 32
REL_MAX_EXACT = REL_BUCKETS // 2
REL_MAX_DIST = 128
R_HEAD_DIM = 64
R_WIDTH = D_MIX - A_WIDTH
R_HEADS = R_WIDTH // R_HEAD_DIM
DECAY_LORA = 96
AAA_LORA = 96
GATE_LORA = 256
GN_EPS = 64e-5
D_FF = 5632
RMS_EPS = 1e-6
N_SUB = 3
A_COLS = (A_WIDTH, KV_RANK, IDX_HEADS * IDX_DIM, IDX_DIM, IDX_HEADS)
R_COLS = (R_WIDTH, R_WIDTH, R_WIDTH, DECAY_LORA, AAA_LORA, GATE_LORA)
A_PROJ = sum(A_COLS)
R_PROJ = sum(R_COLS)
P_IN = A_PROJ + R_PROJ

kernel_name = 'hybrid_dsa_rwkv7_macaron_adaln'


def _split(z, sizes):
    offs = np.cumsum(np.array(sizes))[:-1].tolist()
    return jnp.split(z, offs, axis=-1)


def rms_norm(x, g):
    xf = x.astype(jnp.float32)
    y = xf * lax.rsqrt(jnp.mean(xf * xf, axis=-1, keepdims=True) + RMS_EPS)
    return (y * g.astype(jnp.float32)).astype(x.dtype)


def adaln(h, g, shift, scale):
    return rms_norm(h, g) * (1 + scale[:, None, :]) + shift[:, None, :]


def swiglu(h, w_in, w_out):
    gu = h @ w_in
    g, u = jnp.split(gu, 2, axis=-1)
    return (jax.nn.silu(g) * u) @ w_out


def t5_bucket(dist):
    n = jnp.maximum(dist, 0)
    nf = jnp.maximum(n, 1).astype(jnp.float32)
    large = REL_MAX_EXACT + (jnp.log(nf / REL_MAX_EXACT) / math.log(REL_MAX_DIST / REL_MAX_EXACT)
                             * (REL_BUCKETS - REL_MAX_EXACT)).astype(jnp.int32)
    large = jnp.minimum(large, REL_BUCKETS - 1)
    return jnp.where(n < REL_MAX_EXACT, n, large)


def dsa_mixer(q, c_kv, q_idx, k_idx, w_idx, w_uk, w_uv, t5_bias):
    B, S = q.shape[0], q.shape[1]
    topk = min(TOPK_MAX, S // 4)
    nblk = S // Q_BLOCK
    scale = A_HEAD_DIM ** -0.5
    q_lat = jnp.einsum('bshd,rhd->bshr', q, w_uk)
    key_pos = jnp.arange(S, dtype=jnp.int32)

    def to_blocks(a):
        return jnp.moveaxis(a.reshape((B, nblk, Q_BLOCK) + a.shape[2:]), 1, 0)

    def block_fn(args):
        ql, qi, wi, start = args
        q_pos = start + jnp.arange(Q_BLOCK, dtype=jnp.int32)
        causal = key_pos[None, :] <= q_pos[:, None]
        rel = jax.nn.relu(jnp.einsum('bthd,bsd->bths', qi, k_idx))
        score = jnp.einsum('bths,bth->bts', rel, wi).astype(jnp.float32)
        score = jnp.where(causal[None], score, -jnp.inf)
        _, idx = lax.top_k(score, topk)
        valid = idx <= q_pos[None, :, None]
        c_sel = jax.vmap(lambda cb, ib: cb[ib])(c_kv, idx)
        logits = jnp.einsum('bthr,btkr->bhtk', ql, c_sel).astype(jnp.float32) * scale
        bias = t5_bias[t5_bucket(q_pos[None, :, None] - idx)]
        logits = logits + jnp.moveaxis(bias, -1, 1).astype(jnp.float32)
        logits = jnp.where(valid[:, None], logits, -jnp.inf)
        p = jax.nn.softmax(logits, axis=-1).astype(c_sel.dtype)
        o_lat = jnp.einsum('bhtk,btkr->bthr', p, c_sel)
        return jnp.einsum('bthr,rhd->bthd', o_lat, w_uv)

    starts = jnp.arange(nblk, dtype=jnp.int32) * Q_BLOCK
    out = lax.map(block_fn, (to_blocks(q_lat), to_blocks(q_idx), to_blocks(w_idx), starts))
    return jnp.moveaxis(out, 0, 1).reshape(B, S, A_WIDTH)


def rwkv7_mixer(zr, mu, w0, w2, a0, a2, g2, k_k, k_a, r_k, ln_w, ln_b):
    B, S = zr.shape[0], zr.shape[1]
    f32 = jnp.float32
    z_prev = jnp.pad(zr, ((0, 0), (1, 0), (0, 0)))[:, :-1]
    zm = zr + (z_prev - zr) * mu
    r, k, v, wl, al, gl = _split(zm, R_COLS)
    w = -jax.nn.softplus(-(w0 + jnp.tanh(wl) @ w2).astype(f32)) - 0.5
    decay = jnp.exp(-jnp.exp(w))
    a = jax.nn.sigmoid(a0 + al @ a2)
    g = jax.nn.sigmoid(gl) @ g2
    hd = lambda t: t.reshape(B, S, R_HEADS, R_HEAD_DIM).astype(f32)
    kk = hd(k * k_k)
    kk = kk / jnp.maximum(jnp.sqrt(jnp.sum(kk * kk, axis=-1, keepdims=True)), 1e-12)
    k = k * (1 + (a - 1) * k_a)
    r_h, k_h, v_h, a_h, w_h = hd(r), hd(k), hd(v), hd(a), hd(decay)

    def step(state, inp):
        r_t, w_t, k_t, v_t, kk_t, a_t = inp
        sa = jnp.einsum('bhij,bhj->bhi', state, -kk_t)
        state = (state * w_t[:, :, None, :] + sa[..., None] * (kk_t * a_t)[:, :, None, :]
                 + v_t[..., None] * k_t[:, :, None, :])
        return state, jnp.einsum('bhij,bhj->bhi', state, r_t)

    xs = tuple(jnp.moveaxis(t, 1, 0) for t in (r_h, w_h, k_h, v_h, kk, a_h))
    s0 = jnp.zeros((B, R_HEADS, R_HEAD_DIM, R_HEAD_DIM), f32)
    _, y = lax.scan(step, s0, xs)
    y = jnp.moveaxis(y, 0, 1)
    mean = jnp.mean(y, axis=-1, keepdims=True)
    var = jnp.mean((y - mean) ** 2, axis=-1, keepdims=True)
    y = ((y - mean) * lax.rsqrt(var + GN_EPS)).reshape(B, S, R_WIDTH)
    y = y * ln_w.astype(f32) + ln_b.astype(f32)
    bonus = jnp.sum(r_h * k_h * r_k.astype(f32), axis=-1, keepdims=True) * v_h
    y = (y + bonus.reshape(B, S, R_WIDTH)) * g.astype(f32)
    return y.astype(zr.dtype)


def setup_inputs(seed: int = 0) -> dict:
    key = jax.random.key(seed)
    ks = jax.random.split(key, 32)
    f32 = jnp.float32
    nrm = lambda k, shape, s: jax.random.normal(k, shape, f32) * s
    return {
        'x': nrm(ks[0], (BATCH, SEQ, D_MODEL), 1.0),
        'c': nrm(ks[1], (BATCH, D_MODEL), 1.0),
        't5_bias': nrm(ks[2], (REL_BUCKETS, A_HEADS), 0.5),
        'ada_w': nrm(ks[3], (DEPTH, D_MODEL, N_SUB * 3 * D_MODEL), 0.5 * D_MODEL ** -0.5),
        'ada_b': nrm(ks[4], (DEPTH, N_SUB * 3 * D_MODEL), 0.01),
        'norm_g': 1.0 + nrm(ks[5], (DEPTH, N_SUB, D_MODEL), 0.02),
        'ffn_w_in': nrm(ks[6], (DEPTH, 2, D_MODEL, 2 * D_FF), D_MODEL ** -0.5),
        'ffn_w_out': nrm(ks[7], (DEPTH, 2, D_FF, D_MODEL), D_FF ** -0.5),
        'w_in': nrm(ks[8], (DEPTH, D_MODEL, P_IN), D_MODEL ** -0.5),
        'ckv_norm_g': 1.0 + nrm(ks[9], (DEPTH, KV_RANK), 0.02),
        'w_uk': nrm(ks[10], (DEPTH, KV_RANK, A_HEADS, A_HEAD_DIM), KV_RANK ** -0.5),
        'w_uv': nrm(ks[11], (DEPTH, KV_RANK, A_HEADS, A_HEAD_DIM), KV_RANK ** -0.5),
        'rwkv_mu': jax.random.uniform(ks[12], (DEPTH, R_PROJ), f32, 0.0, 1.0),
        'rwkv_w0': nrm(ks[13], (DEPTH, R_WIDTH), 0.5),
        'rwkv_w2': nrm(ks[14], (DEPTH, DECAY_LORA, R_WIDTH), 0.5 * DECAY_LORA ** -0.5),
        'rwkv_a0': nrm(ks[15], (DEPTH, R_WIDTH), 0.5),
        'rwkv_a2': nrm(ks[16], (DEPTH, AAA_LORA, R_WIDTH), AAA_LORA ** -0.5),
        'rwkv_g2': nrm(ks[17], (DEPTH, GATE_LORA, R_WIDTH), GATE_LORA ** -0.5),
        'rwkv_k_k': 0.85 + nrm(ks[18], (DEPTH, R_WIDTH), 0.02),
        'rwkv_k_a': 1.0 + nrm(ks[19], (DEPTH, R_WIDTH), 0.02),
        'rwkv_r_k': nrm(ks[20], (DEPTH, R_HEADS, R_HEAD_DIM), 0.1),
        'rwkv_ln_w': 1.0 + nrm(ks[21], (DEPTH, R_WIDTH), 0.02),
        'rwkv_ln_b': nrm(ks[22], (DEPTH, R_WIDTH), 0.01),
        'w_out': nrm(ks[23], (DEPTH, D_MIX, D_MODEL), D_MIX ** -0.5),
        'final_norm_g': 1.0 + nrm(ks[24], (D_MODEL,), 0.02),
    }


def reference(x, c, t5_bias, ada_w, ada_b, norm_g, ffn_w_in, ffn_w_out, w_in, ckv_norm_g, w_uk, w_uv,
              rwkv_mu, rwkv_w0, rwkv_w2, rwkv_a0, rwkv_a2, rwkv_g2, rwkv_k_k, rwkv_k_a, rwkv_r_k,
              rwkv_ln_w, rwkv_ln_b, w_out, final_norm_g):
    B, S, D = x.shape
    c_act = jax.nn.silu(c)
    h = x
    for l in range(DEPTH):
        mod = (c_act @ ada_w[l] + ada_b[l]).reshape(B, N_SUB, 3, D)
        hn = adaln(h, norm_g[l, 0], mod[:, 0, 0], mod[:, 0, 1])
        h = h + 0.5 * mod[:, 0, 2, None, :] * swiglu(hn, ffn_w_in[l, 0], ffn_w_out[l, 0])
        hn = adaln(h, norm_g[l, 1], mod[:, 1, 0], mod[:, 1, 1])
        z = hn @ w_in[l]
        za, zr = z[..., :A_PROJ], z[..., A_PROJ:]
        q, ckv, qi, ki, wi = _split(za, A_COLS)
        ckv = rms_norm(ckv, ckv_norm_g[l])
        wi = wi * (IDX_HEADS * IDX_DIM) ** -0.5
        o_a = dsa_mixer(q.reshape(B, S, A_HEADS, A_HEAD_DIM), ckv,
                        qi.reshape(B, S, IDX_HEADS, IDX_DIM), ki, wi, w_uk[l], w_uv[l], t5_bias)
        o_r = rwkv7_mixer(zr, rwkv_mu[l], rwkv_w0[l], rwkv_w2[l], rwkv_a0[l], rwkv_a2[l], rwkv_g2[l],
                          rwkv_k_k[l], rwkv_k_a[l], rwkv_r_k[l], rwkv_ln_w[l], rwkv_ln_b[l])
        o = jnp.concatenate([o_a, o_r], axis=-1) @ w_out[l]
        h = h + mod[:, 1, 2, None, :] * o
        hn = adaln(h, norm_g[l, 2], mod[:, 2, 0], mod[:, 2, 1])
        h = h + 0.5 * mod[:, 2, 2, None, :] * swiglu(hn, ffn_w_in[l, 1], ffn_w_out[l, 1])
    return rms_norm(h, final_norm_g)
```

```cpp
#include <hip/hip_runtime.h>
#include <cstdio>
#include <cstdint>

#ifndef REPK
#define REPK -1
#endif
constexpr int BATCH = 4, SEQ = 4096, D = 2048, DEPTH = 2, M = BATCH * SEQ;
constexpr int FF = 5632, NFI = 2 * FF;
constexpr int PIN = 5904;
constexpr int NZ = 7168;
constexpr int ZC_QLAT = 0, ZC_CKV = 2048, ZC_QIDX = 2304, ZC_KIDX = 3328, ZC_WIDX = 3392, ZC_WL = 3408, ZC_AL = 3504, ZC_GL = 3600, ZC_R = 4096, ZC_K = 5120, ZC_V = 6144;
constexpr int KO = 3072;
constexpr int TOPK = 256;
constexpr int NMOD = 9 * D;
constexpr float RMS_EPS = 1e-6f, GN_EPS = 64e-5f;
constexpr int CH = 64, NCH = SEQ / CH;

constexpr size_t MiB = 1u << 20;
constexpr size_t WS_CTL = 0, CTL_ZERO_BYTES = 1 * MiB;
constexpr size_t WS_MOD = 1 * MiB;
constexpr size_t WS_WFI = 2 * MiB, WFI_ONE = (size_t)NFI * D * 2;
constexpr size_t WS_WFO = 178 * MiB, WFO_ONE = (size_t)D * FF * 2;
constexpr size_t WS_WIN = 266 * MiB, WIN_ONE = (size_t)NZ * D * 2;
constexpr size_t WS_WOUT = 322 * MiB, WOUT_ONE = (size_t)D * KO * 2;
constexpr size_t WS_WLORA = 346 * MiB, WLORA_ONE = (size_t)1024 * 256 * 2;
constexpr size_t WS_HN = 350 * MiB;
constexpr size_t WS_ACT = 414 * MiB;
constexpr size_t WS_Z = 590 * MiB;
constexpr size_t WS_IDX = 814 * MiB;
constexpr size_t WS_CKV = 822 * MiB;
constexpr size_t WS_R = 830 * MiB, WS_V = 894 * MiB, WS_KK = 958 * MiB, WS_K = 1022 * MiB, WS_BETA = 1086 * MiB, WS_DEC = 1150 * MiB;
constexpr size_t WS_O = 1214 * MiB;
constexpr size_t WS_END = 1310 * MiB;
constexpr size_t WS_WINQ = WS_ACT, WS_WOUTTA = WS_ACT + 8 * MiB, WS_BDUK = WS_ACT + 16 * MiB, WS_BDUV = WS_ACT + 24 * MiB;
constexpr size_t WS_LA = WS_ACT;
constexpr size_t WS_G = WS_ACT + 24 * MiB;
constexpr size_t WS_PT = WS_ACT + 56 * MiB;
constexpr size_t WS_ST = WS_ACT + 88 * MiB;
constexpr size_t WS_RHO = WS_R + 32 * MiB, WS_QT = WS_V + 32 * MiB, WS_ZLOC = WS_KK + 32 * MiB;

constexpr int CW_BAR = 4096;
constexpr int CW_WQ = 16384;

constexpr int SCR_BYTES = 143360;
constexpr int LDSCTL_OFF = SCR_BYTES, MISC_OFF = LDSCTL_OFF + 320;
constexpr int LDS_BYTES = 147456;
constexpr int NWAVES = 8, NTHR = NWAVES * 64;

#define GAS __attribute__((address_space(1)))
#define LAS __attribute__((address_space(3)))
#define CAS __attribute__((address_space(4)))
typedef unsigned short bf16;
typedef unsigned v4u __attribute__((ext_vector_type(4)));
typedef unsigned v2u __attribute__((ext_vector_type(2)));
typedef float f32x4 __attribute__((ext_vector_type(4)));
typedef float f32x2 __attribute__((ext_vector_type(2)));
typedef float f32x16 __attribute__((ext_vector_type(16)));
typedef short bf16x8 __attribute__((ext_vector_type(8)));
typedef short bf16x4 __attribute__((ext_vector_type(4)));
typedef GAS unsigned gu32;
#define RLX_AGENT __ATOMIC_RELAXED, __HIP_MEMORY_SCOPE_AGENT
#define LDS_WAIT() asm volatile("s_waitcnt lgkmcnt(0)" ::: "memory")
#define VM_WAIT() asm volatile("s_waitcnt vmcnt(0)" ::: "memory")
__device__ __forceinline__ unsigned f2bf(float f) { unsigned u = __builtin_bit_cast(unsigned, f); return (u + 0x7fffu + ((u >> 16) & 1u)) >> 16; }
typedef __bf16 hwbf2 __attribute__((ext_vector_type(2)));
__device__ __forceinline__ unsigned pk2(float lo, float hi) { const f32x2 v = {lo, hi}; return __builtin_bit_cast(unsigned, __builtin_convertvector(v, hwbf2)); }
__device__ __forceinline__ float bflo(unsigned w) { return __builtin_bit_cast(float, w << 16); }
__device__ __forceinline__ float bfhi(unsigned w) { return __builtin_bit_cast(float, w & 0xffff0000u); }
__device__ __forceinline__ float bf2f(bf16 b) { return __builtin_bit_cast(float, ((unsigned)b) << 16); }
__device__ __forceinline__ float wave_sum(float v) {
#pragma unroll
    for (int o = 1; o < 64; o <<= 1) v += __shfl_xor(v, o);
    return v;
}
__device__ __forceinline__ float fast_exp(float x) { return __builtin_amdgcn_exp2f(x * 1.44269504089f); }
__device__ __forceinline__ float fast_sigmoid(float x) { return __builtin_amdgcn_rcpf(1.0f + fast_exp(-x)); }

__device__ __forceinline__ int lane_id() { unsigned m = ~0u; asm volatile("" : "+s"(m)); return (int)__builtin_amdgcn_mbcnt_hi(m, __builtin_amdgcn_mbcnt_lo(m, 0u)); }
__device__ __forceinline__ int wtid(int wave) { return wave * 64 + lane_id(); }
namespace pg8 {
#define PG8_LAS __attribute__((address_space(3)))
typedef unsigned short bf16_t;
typedef short bf16x8 __attribute__((ext_vector_type(8)));
typedef float f32x4 __attribute__((ext_vector_type(4)));
typedef unsigned u32x4 __attribute__((ext_vector_type(4)));
constexpr int BM = 256, BK = 64, HALF = 128, HTB = HALF * BK * 2  , STAGE_BYTES = 8 * HTB, NXCD = 8, WGM = 8;

__host__ __device__ __forceinline__ int lds_byte(int r, int c) { const int st = (r >> 4) * 2 + (c >> 5), rr = r & 15, cc = c & 31, ob = rr * 64 + cc * 2; return st * 1024 + (ob ^ (((ob >> 9) & 1) << 5)); }
__host__ __device__ __forceinline__ void stage_rc(int b, int& R, int& C) { const int st = b / 1024, sb = b % 1024, swz = sb ^ (((sb >> 9) & 1) << 5); R = (st >> 1) * 16 + swz / 64; C = (st & 1) * 32 + (swz % 64) / 2; }
__host__ __device__ __forceinline__ int perm32(int rho) { const int n = rho >> 4, i = rho & 15; return 8 * (i >> 2) + 4 * n + (i & 3); }

struct Unit { int pm, pn; };
struct Gemm { const bf16_t* A; const bf16_t* Bt; int M, N, K; };

struct StaticOrder {
    int nM, nN, nwg, G, c, wgm;
    __host__ __device__ void init(int M, int N, int G_, int c_, int wgm_ = WGM) { nM = M / BM; nN = N / BM; nwg = nM * nN; G = G_; c = c_; wgm = wgm_; }
    __host__ __device__ bool next(int i, Unit& u) const {
        const long L = (long)i * G + c; if (L >= nwg) return false;
        int wgid = (int)L; { const int q = nwg / NXCD, r = nwg % NXCD, xcd = wgid % NXCD, off = wgid / NXCD; wgid = (xcd < r ? xcd * (q + 1) : r * (q + 1) + (xcd - r) * q) + off; }
        const int nig = wgm * nN, gid = wgid / nig, fm = gid * wgm, gsz = (nM - fm) < wgm ? (nM - fm) : wgm;
        u.pm = fm + ((wgid % nig) % gsz); u.pn = (wgid % nig) / gsz; return true;
    }
    __device__ __forceinline__ void a_ready(const Unit&) const {}
    __device__ __forceinline__ size_t a_off(const Unit&) const { return 0; }
    __device__ __forceinline__ void done(const Unit&) const {}
};

__device__ __forceinline__ unsigned cvt_pk_bf16(float lo, float hi) { unsigned r; asm volatile("v_cvt_pk_bf16_f32 %0, %1, %2" : "=v"(r) : "v"(lo), "v"(hi)); return r; }
__device__ __forceinline__ unsigned cvt_pk_bf16_safe(float lo, float hi) { unsigned r; asm volatile("s_nop 1\n\tv_cvt_pk_bf16_f32 %0, %1, %2" : "=v"(r) : "v"(lo), "v"(hi)); return r; }
typedef float f32x2 __attribute__((ext_vector_type(2)));

struct EpiStoreBf16 {
    static constexpr bool PERM = true, AFTER_DRAIN = false;
    bf16_t* O; int ldc;
    __device__ __forceinline__ void operator()(const f32x4 (&acc)[2][2][4][2], const Unit& u, int wr, int wc, int fr, int fq) const {
        const int row0 = u.pm * BM + wr * 64 + fr, col0 = u.pn * BM + wc * 32 + 8 * fq;
#pragma unroll
        for (int ai = 0; ai < 2; ++ai)
#pragma unroll
            for (int m = 0; m < 4; ++m) { bf16_t* rowp = O + (size_t)(row0 + ai * HALF + m * 16) * ldc + col0;
#pragma unroll
                for (int bj = 0; bj < 2; ++bj) { const f32x4 v0 = acc[ai][bj][m][0], v1 = acc[ai][bj][m][1];
                    u32x4 w; w.x = cvt_pk_bf16(v0[0], v0[1]); w.y = cvt_pk_bf16(v0[2], v0[3]); w.z = cvt_pk_bf16(v1[0], v1[1]); w.w = cvt_pk_bf16(v1[2], v1[3]);
                    *(u32x4*)(rowp + bj * HALF) = w; } }
    }
};
struct EpiSwiglu {
    static constexpr bool PERM = true, AFTER_DRAIN = false;
    bf16_t* O; int ldc;
    __device__ __forceinline__ void operator()(const f32x4 (&acc)[2][2][4][2], const Unit& u, int wr, int wc, int fr, int fq) const {
        const int row0 = u.pm * BM + wr * 64 + fr, col0 = u.pn * HALF + wc * 32 + 8 * fq;
#pragma unroll
        for (int ai = 0; ai < 2; ++ai)
#pragma unroll
            for (int m = 0; m < 4; ++m) { bf16_t* rowp = O + (size_t)(row0 + ai * HALF + m * 16) * ldc + col0;
                f32x2 h[4];
#pragma unroll
                for (int n = 0; n < 2; ++n) { const f32x4 g = acc[ai][0][m][n], up = acc[ai][1][m][n];
#pragma unroll
                    for (int j = 0; j < 2; ++j) { const f32x2 g2 = {g[2 * j], g[2 * j + 1]}, u2 = {up[2 * j], up[2 * j + 1]};
                        const f32x2 t = g2 * -1.44269504089f; f32x2 d; d.x = __builtin_amdgcn_exp2f(t.x); d.y = __builtin_amdgcn_exp2f(t.y); d = d + 1.0f;
                        f32x2 r; r.x = __builtin_amdgcn_rcpf(d.x); r.y = __builtin_amdgcn_rcpf(d.y);
                        h[2 * n + j] = (g2 * u2) * r; } }
                u32x4 w; w.x = cvt_pk_bf16(h[0].x, h[0].y); w.y = cvt_pk_bf16(h[1].x, h[1].y); w.z = cvt_pk_bf16(h[2].x, h[2].y); w.w = cvt_pk_bf16(h[3].x, h[3].y);
                *(u32x4*)rowp = w; }
    }
};
struct EpiResid {
    static constexpr bool PERM = false, AFTER_DRAIN = false;
    const float* base; float* out; int ldc; const float* gate; int gate_bstride; float coef;
    __device__ __forceinline__ void operator()(const f32x4 (&acc)[2][2][4][2], const Unit& u, int wr, int wc, int fr, int fq) const {
        const int row0 = u.pm * BM + wr * 64 + fr, col0 = u.pn * BM + wc * 32 + 4 * fq;
        const float* gp = gate + (size_t)((u.pm * BM) >> 12) * gate_bstride + col0;
        f32x4 gv[2][2];
#pragma unroll
        for (int bj = 0; bj < 2; ++bj)
#pragma unroll
            for (int n = 0; n < 2; ++n) gv[bj][n] = *(const f32x4*)(gp + bj * HALF + n * 16) * coef;
        const float* bp = base + (size_t)row0 * ldc + col0; float* op = out + (size_t)row0 * ldc + col0;
        f32x4 b0[4][2][2], b1[4][2][2];
#pragma unroll
        for (int m = 0; m < 4; ++m)
#pragma unroll
            for (int bj = 0; bj < 2; ++bj)
#pragma unroll
                for (int n = 0; n < 2; ++n) b0[m][bj][n] = *(const f32x4*)(bp + (size_t)(m * 16) * ldc + bj * HALF + n * 16);
#pragma unroll
        for (int m = 0; m < 4; ++m)
#pragma unroll
            for (int bj = 0; bj < 2; ++bj)
#pragma unroll
                for (int n = 0; n < 2; ++n) b0[m][bj][n] += gv[bj][n] * acc[0][bj][m][n];
#pragma unroll
        for (int m = 0; m < 4; ++m)
#pragma unroll
            for (int bj = 0; bj < 2; ++bj)
#pragma unroll
                for (int n = 0; n < 2; ++n) b1[m][bj][n] = *(const f32x4*)(bp + (size_t)(HALF + m * 16) * ldc + bj * HALF + n * 16);
#pragma unroll
        for (int m = 0; m < 4; ++m)
#pragma unroll
            for (int bj = 0; bj < 2; ++bj)
#pragma unroll
                for (int n = 0; n < 2; ++n) *(f32x4*)(op + (size_t)(m * 16) * ldc + bj * HALF + n * 16) = b0[m][bj][n];
#pragma unroll
        for (int m = 0; m < 4; ++m)
#pragma unroll
            for (int bj = 0; bj < 2; ++bj)
#pragma unroll
                for (int n = 0; n < 2; ++n) *(f32x4*)(op + (size_t)(HALF + m * 16) * ldc + bj * HALF + n * 16) = b1[m][bj][n] + gv[bj][n] * acc[1][bj][m][n];
    }
};
template <bool BASE32> struct EpiResidH {
    static constexpr bool PERM = true, AFTER_DRAIN = false;
    const void* base; bf16_t* out; int ldc; const float* gate; int gate_bstride; float coef;
    __device__ __forceinline__ void operator()(const f32x4 (&acc)[2][2][4][2], const Unit& u, int wr, int wc, int fr, int fq) const {
        const int row0 = u.pm * BM + wr * 64 + fr, col0 = u.pn * BM + wc * 32 + 8 * fq;
        const float* gp = gate + (size_t)((u.pm * BM) >> 12) * gate_bstride + col0;
        f32x4 gv[2][2];
#pragma unroll
        for (int bj = 0; bj < 2; ++bj)
#pragma unroll
            for (int n = 0; n < 2; ++n) gv[bj][n] = *(const f32x4*)(gp + bj * HALF + 4 * n) * coef;
        bf16_t* op = out + (size_t)row0 * ldc + col0;
        if constexpr (!BASE32) {
            const bf16_t* bp = (const bf16_t*)base + (size_t)row0 * ldc + col0;
            u32x4 bb[2][4][2];
#pragma unroll
            for (int ai = 0; ai < 2; ++ai)
#pragma unroll
                for (int m = 0; m < 4; ++m)
#pragma unroll
                    for (int bj = 0; bj < 2; ++bj) bb[ai][m][bj] = *(const u32x4*)(bp + (size_t)(ai * HALF + m * 16) * ldc + bj * HALF);
#pragma unroll
            for (int ai = 0; ai < 2; ++ai)
#pragma unroll
                for (int m = 0; m < 4; ++m)
#pragma unroll
                    for (int bj = 0; bj < 2; ++bj) { const u32x4 b = bb[ai][m][bj]; const f32x4 a0 = acc[ai][bj][m][0] * gv[bj][0], a1 = acc[ai][bj][m][1] * gv[bj][1];
                        u32x4 w; w.x = cvt_pk_bf16(bflo(b.x) + a0[0], bfhi(b.x) + a0[1]); w.y = cvt_pk_bf16(bflo(b.y) + a0[2], bfhi(b.y) + a0[3]);
                        w.z = cvt_pk_bf16(bflo(b.z) + a1[0], bfhi(b.z) + a1[1]); w.w = cvt_pk_bf16(bflo(b.w) + a1[2], bfhi(b.w) + a1[3]);
                        *(u32x4*)(op + (size_t)(ai * HALF + m * 16) * ldc + bj * HALF) = w; }
        } else {
            const float* bp = (const float*)base + (size_t)row0 * ldc + col0;
#pragma unroll
            for (int ai = 0; ai < 2; ++ai) {
                f32x4 bf[4][2][2];
#pragma unroll
                for (int m = 0; m < 4; ++m)
#pragma unroll
                    for (int bj = 0; bj < 2; ++bj)
#pragma unroll
                        for (int n = 0; n < 2; ++n) bf[m][bj][n] = *(const f32x4*)(bp + (size_t)(ai * HALF + m * 16) * ldc + bj * HALF + 4 * n);
#pragma unroll
                for (int m = 0; m < 4; ++m)
#pragma unroll
                    for (int bj = 0; bj < 2; ++bj) { const f32x4 a0 = bf[m][bj][0] + acc[ai][bj][m][0] * gv[bj][0], a1 = bf[m][bj][1] + acc[ai][bj][m][1] * gv[bj][1];
                        u32x4 w; w.x = cvt_pk_bf16(a0[0], a0[1]); w.y = cvt_pk_bf16(a0[2], a0[3]); w.z = cvt_pk_bf16(a1[0], a1[1]); w.w = cvt_pk_bf16(a1[2], a1[3]);
                        *(u32x4*)(op + (size_t)(ai * HALF + m * 16) * ldc + bj * HALF) = w; }
            }
        }
    }
};
template <int MODE> struct EpiLora {
    static constexpr bool PERM = (MODE == 2), AFTER_DRAIN = false;
    float* o0; bf16_t* o0h; bf16_t* o1h; bf16_t* o2; const bf16_t* auxh; const float* v0; const float* v1;
    __device__ __forceinline__ void operator()(const f32x4 (&acc)[2][2][4][2], const Unit& u, int wr, int wc, int fr, int fq) const {
        const int row0 = u.pm * BM + wr * 64 + fr;
        if constexpr (MODE == 2) {
            const int col0 = u.pn * BM + wc * 32 + 8 * fq;
#pragma unroll
            for (int ai = 0; ai < 2; ++ai)
#pragma unroll
                for (int m = 0; m < 4; ++m) { bf16_t* rowp = o2 + (size_t)(row0 + ai * HALF + m * 16) * 1024 + col0;
#pragma unroll
                    for (int bj = 0; bj < 2; ++bj) { const f32x4 a0 = acc[ai][bj][m][0], a1 = acc[ai][bj][m][1];
                        u32x4 w; w.x = cvt_pk_bf16(a0[0], a0[1]); w.y = cvt_pk_bf16(a0[2], a0[3]); w.z = cvt_pk_bf16(a1[0], a1[1]); w.w = cvt_pk_bf16(a1[2], a1[3]);
                        *(u32x4*)(rowp + bj * HALF) = w; } }
        } else {
            const int col0 = u.pn * BM + wc * 32 + 4 * fq;
#pragma unroll
            for (int bj = 0; bj < 2; ++bj)
#pragma unroll
                for (int n = 0; n < 2; ++n) {
                    const int cc = col0 + bj * HALF + n * 16;
                    const f32x4 c0 = *(const f32x4*)(v0 + cc);
#pragma unroll
                    for (int ai = 0; ai < 2; ++ai)
#pragma unroll
                        for (int m = 0; m < 4; ++m) { const size_t o = (size_t)(row0 + ai * HALF + m * 16) * 1024 + cc; const f32x4 x = acc[ai][bj][m][n] + c0;
                            if constexpr (MODE == 0) { f32x4 r;
#pragma unroll
                                for (int j = 0; j < 4; ++j) { const float nx = -x[j];
                                    const float sp = fmaxf(nx, 0.f) + 0.69314718056f * __builtin_amdgcn_logf(1.0f + __builtin_amdgcn_exp2f(-1.44269504089f * fabsf(nx)));
                                    r[j] = __builtin_amdgcn_exp2f(-1.44269504089f * __builtin_amdgcn_exp2f(-1.44269504089f * (sp + 0.5f))); }
                                *(f32x4*)(o0 + o) = r; }
                            else { typedef unsigned u32x2 __attribute__((ext_vector_type(2))); float a[4];
#pragma unroll
                                for (int j = 0; j < 4; ++j) a[j] = __builtin_amdgcn_rcpf(1.0f + __builtin_amdgcn_exp2f(-1.44269504089f * x[j]));
                                u32x2 ao; ao.x = cvt_pk_bf16_safe(a[0], a[1]); ao.y = cvt_pk_bf16_safe(a[2], a[3]); *(u32x2*)(o1h + o) = ao; }
                            asm volatile("" ::: "memory"); }
                }
        }
    }
};

struct LoraOrder : StaticOrder {
    size_t a_stride;
    __device__ __forceinline__ size_t a_off(const Unit& u) const { return (size_t)(u.pn >> 2) * a_stride; }
};
struct EpiLoraAll {
    static constexpr bool PERM = false, AFTER_DRAIN = false;
    float* dec; bf16_t* kh; bf16_t* betah; bf16_t* gh; const bf16_t* kkh; const float* w0; const float* a0; const float* ka;
    __device__ __forceinline__ void operator()(const f32x4 (&acc)[2][2][4][2], const Unit& u, int wr, int wc, int fr, int fq) const {
        typedef unsigned u32x2 __attribute__((ext_vector_type(2)));
        const int mode = u.pn >> 2, row0 = u.pm * BM + wr * 64 + fr, col0 = (u.pn & 3) * BM + wc * 32 + 4 * fq;
#pragma unroll
        for (int bj = 0; bj < 2; ++bj)
#pragma unroll
            for (int n = 0; n < 2; ++n) {
                const int cc = col0 + bj * HALF + n * 16;
                f32x4 c0 = {0.f, 0.f, 0.f, 0.f}, c1 = {0.f, 0.f, 0.f, 0.f};
                if (mode == 0) c0 = *(const f32x4*)(w0 + cc); else if (mode == 1) { c0 = *(const f32x4*)(a0 + cc); c1 = *(const f32x4*)(ka + cc); }
#pragma unroll
                for (int ai = 0; ai < 2; ++ai)
#pragma unroll
                    for (int m = 0; m < 4; ++m) { const size_t o = (size_t)(row0 + ai * HALF + m * 16) * 1024 + cc; const f32x4 x = acc[ai][bj][m][n] + c0;
                        if (mode == 0) { f32x4 r;
#pragma unroll
                            for (int j = 0; j < 4; ++j) { const float nx = -x[j];
                                const float sp = fmaxf(nx, 0.f) + 0.69314718056f * __builtin_amdgcn_logf(1.0f + __builtin_amdgcn_exp2f(-1.44269504089f * fabsf(nx)));
                                r[j] = __builtin_amdgcn_exp2f(-1.44269504089f * __builtin_amdgcn_exp2f(-1.44269504089f * (sp + 0.5f))); }
                            *(f32x4*)(dec + o) = r; }
                        else if (mode == 1) {
                            const u32x2 kw = *(const u32x2*)(kh + o), kkw = *(const u32x2*)(kkh + o);
                            const float kv[4] = {__builtin_bit_cast(float, kw.x << 16), __builtin_bit_cast(float, kw.x & 0xffff0000u), __builtin_bit_cast(float, kw.y << 16), __builtin_bit_cast(float, kw.y & 0xffff0000u)};
                            const float kkv[4] = {__builtin_bit_cast(float, kkw.x << 16), __builtin_bit_cast(float, kkw.x & 0xffff0000u), __builtin_bit_cast(float, kkw.y << 16), __builtin_bit_cast(float, kkw.y & 0xffff0000u)};
                            float kn[4], bt[4];
#pragma unroll
                            for (int j = 0; j < 4; ++j) { const float a = __builtin_amdgcn_rcpf(1.0f + __builtin_amdgcn_exp2f(-1.44269504089f * x[j])); kn[j] = kv[j] * (1.0f + (a - 1.0f) * c1[j]); bt[j] = kkv[j] * a; }
                            u32x2 ko, bo; ko.x = cvt_pk_bf16(kn[0], kn[1]); ko.y = cvt_pk_bf16(kn[2], kn[3]); bo.x = cvt_pk_bf16(bt[0], bt[1]); bo.y = cvt_pk_bf16(bt[2], bt[3]);
                            *(u32x2*)(kh + o) = ko; *(u32x2*)(betah + o) = bo; }
                        else { u32x2 go; go.x = cvt_pk_bf16(x[0], x[1]); go.y = cvt_pk_bf16(x[2], x[3]); *(u32x2*)(gh + o) = go; }
                        asm volatile("" ::: "memory"); }
            }
    }
};
template <class Epi, class Sched, bool ALIGN_EPI = false, bool SP2 = false>
__device__ __forceinline__ void gemm_phase(PG8_LAS unsigned char* lds, const Gemm g, const Sched& S, const Epi& E, const int wave_) {
    int tid_l = wtid(wave_); asm volatile("" : "+v"(tid_l));
    const int tid = tid_l, wid = __builtin_amdgcn_readfirstlane(tid >> 6), lane = tid & 63, wr = wid >> 2, wc = wid & 3, fr = lane & 15, fq = lane >> 4;
    const int K = g.K, nt = K / BK;
    unsigned voffA[2], voffB[2];
#pragma unroll
    for (int i = 0; i < 2; ++i) { int R, C; stage_rc(tid * 16 + i * 8192, R, C); const int Rb = Epi::PERM ? ((R & ~31) + perm32(R & 31)) : R;
        voffA[i] = (unsigned)(R * K + C) * 2u; voffB[i] = (unsigned)(Rb * K + C) * 2u; }
    const size_t kstep = (size_t)(BK * 2);
    const size_t hstep = (size_t)HALF * K * 2;
    const size_t tstep = 2 * hstep;
    const unsigned ldsw = (unsigned)wid * 1024u;
    const int aoff = lds_byte(wr * 64 + fr, fq * 8), boff = lds_byte(wc * 32 + fr, fq * 8);
#define PG8_SA(b, h) (((b) * 2 + (h)) * HTB)
#define PG8_SB(b, h) ((4 + (b) * 2 + (h)) * HTB)
#define PG8_STAGE(bufoff, gbase, voff) do { _Pragma("unroll") for (int _i = 0; _i < 2; ++_i) \
        __builtin_amdgcn_global_load_lds((const unsigned*)((const char*)(gbase) + (voff)[_i]), (PG8_LAS unsigned*)(lds + (bufoff) + ldsw + _i * 8192), 16, 0, 0); } while (0)
#define PG8_LDA(dst, b, h) do { _Pragma("unroll") for (int m = 0; m < 4; ++m) _Pragma("unroll") for (int k = 0; k < 2; ++k) dst[m][k] = *(const PG8_LAS bf16x8*)(lds + PG8_SA(b, h) + aoff + m * 2048 + k * 1024); } while (0)
#define PG8_LDB(dst, b, h) do { _Pragma("unroll") for (int n = 0; n < 2; ++n) _Pragma("unroll") for (int k = 0; k < 2; ++k) dst[n][k] = *(const PG8_LAS bf16x8*)(lds + PG8_SB(b, h) + boff + n * 2048 + k * 1024); } while (0)
#define PG8_MMA(ai, bj, At, Bt) do { __builtin_amdgcn_s_setprio(1); _Pragma("unroll") for (int m = 0; m < 4; ++m) _Pragma("unroll") for (int n = 0; n < 2; ++n) _Pragma("unroll") for (int k = 0; k < 2; ++k) \
        acc[ai][bj][m][n] = __builtin_amdgcn_mfma_f32_16x16x32_bf16(Bt[n][k], At[m][k], acc[ai][bj][m][n], 0, 0, 0); __builtin_amdgcn_s_setprio(0); } while (0)
#define PG8_WAIT_V(n) asm volatile("s_waitcnt vmcnt(" #n ")" ::: "memory")
#define PG8_WAIT_L(n) asm volatile("s_waitcnt lgkmcnt(" #n ")" ::: "memory")
#define PG8_BAR __builtin_amdgcn_s_barrier()
#define PG8_SCHED __builtin_amdgcn_sched_barrier(0)
    Unit cur, nxt; int ui = 0;
    if (!S.next(0, cur)) return;
    f32x4 acc[2][2][4][2];
#pragma unroll
    for (int a = 0; a < 2; ++a)
#pragma unroll
        for (int b = 0; b < 2; ++b)
#pragma unroll
            for (int m = 0; m < 4; ++m)
#pragma unroll
                for (int n = 0; n < 2; ++n) acc[a][b][m][n] = (f32x4){0.f, 0.f, 0.f, 0.f};
    bf16x8 At[4][2], B0[2][2], B1[2][2];
    const char* cA = (const char*)g.A + S.a_off(cur) + (size_t)cur.pm * tstep; const char* cB = (const char*)g.Bt + (size_t)cur.pn * tstep;
    S.a_ready(cur);
    if constexpr (SP2) {
        PG8_STAGE(PG8_SB(0, 0), cB, voffB); PG8_STAGE(PG8_SB(0, 1), cB + hstep, voffB); PG8_STAGE(PG8_SA(0, 0), cA, voffA); PG8_STAGE(PG8_SA(0, 1), cA + hstep, voffA);
        if (wr == 1) PG8_BAR;
        PG8_WAIT_V(2); PG8_BAR;
        PG8_STAGE(PG8_SB(1, 0), cB + kstep, voffB); PG8_STAGE(PG8_SA(1, 0), cA + kstep, voffA); PG8_STAGE(PG8_SB(1, 1), cB + hstep + kstep, voffB);
        PG8_WAIT_V(6); PG8_BAR;
    } else {
        PG8_STAGE(PG8_SB(0, 0), cB, voffB); PG8_STAGE(PG8_SA(0, 0), cA, voffA); PG8_STAGE(PG8_SB(0, 1), cB + hstep, voffB); PG8_STAGE(PG8_SA(0, 1), cA + hstep, voffA);
        if (wr == 1) PG8_BAR;
        PG8_WAIT_V(4); PG8_BAR;
        PG8_STAGE(PG8_SB(1, 0), cB + kstep, voffB); PG8_STAGE(PG8_SA(1, 0), cA + kstep, voffA); PG8_STAGE(PG8_SB(1, 1), cB + hstep + kstep, voffB);
        PG8_WAIT_V(6); PG8_BAR;
    }
    for (;;) {
        const bool has_next = S.next(ui + 1, nxt);
        const char* nA = has_next ? (const char*)g.A + S.a_off(nxt) + (size_t)nxt.pm * tstep : cA; const char* nB = has_next ? (const char*)g.Bt + (size_t)nxt.pn * tstep : cB;
        for (int t = 0; t < nt; t += 2) {
            const bool last = (t == nt - 2);
            const char* a1 = cA + (size_t)(t + 1) * kstep;
            const char* a2 = last ? nA : cA + (size_t)(t + 2) * kstep; const char* b2 = last ? nB : cB + (size_t)(t + 2) * kstep;
            const char* a3 = a2 + kstep; const char* b3 = b2 + kstep;
            if (last && has_next) S.a_ready(nxt);
            if constexpr (SP2) {
            PG8_LDB(B0, 0, 0); PG8_LDB(B1, 0, 1); PG8_SCHED; PG8_LDA(At, 0, 0); PG8_STAGE(PG8_SA(1, 1), a1 + hstep, voffA);
            PG8_WAIT_V(8); PG8_WAIT_L(0); PG8_BAR; PG8_MMA(0, 0, At, B0); PG8_MMA(0, 1, At, B1); PG8_BAR; PG8_SCHED;
            PG8_LDA(At, 0, 1); PG8_STAGE(PG8_SB(0, 0), b2, voffB); PG8_STAGE(PG8_SB(0, 1), b2 + hstep, voffB); PG8_STAGE(PG8_SA(0, 0), a2, voffA);
            PG8_WAIT_V(8); PG8_WAIT_L(0); PG8_BAR; PG8_MMA(1, 0, At, B0); PG8_MMA(1, 1, At, B1); PG8_BAR; PG8_SCHED;
            PG8_LDB(B0, 1, 0); PG8_LDB(B1, 1, 1); PG8_SCHED; PG8_LDA(At, 1, 0); PG8_STAGE(PG8_SA(0, 1), a2 + hstep, voffA);
            PG8_WAIT_V(8); PG8_WAIT_L(0); PG8_BAR; PG8_MMA(0, 0, At, B0); PG8_MMA(0, 1, At, B1); PG8_BAR; PG8_SCHED;
            PG8_LDA(At, 1, 1); PG8_STAGE(PG8_SB(1, 0), b3, voffB); PG8_STAGE(PG8_SB(1, 1), b3 + hstep, voffB); PG8_STAGE(PG8_SA(1, 0), a3, voffA);
            PG8_WAIT_V(8); PG8_WAIT_L(0); PG8_BAR; PG8_MMA(1, 0, At, B0); PG8_MMA(1, 1, At, B1); PG8_BAR; PG8_SCHED;
            } else {
            PG8_LDB(B0, 0, 0); PG8_SCHED; PG8_LDA(At, 0, 0); PG8_STAGE(PG8_SA(1, 1), a1 + hstep, voffA);
            PG8_WAIT_L(8); PG8_BAR; PG8_WAIT_L(0); PG8_MMA(0, 0, At, B0); PG8_BAR; PG8_SCHED;
            PG8_LDB(B1, 0, 1); PG8_STAGE(PG8_SB(0, 0), b2, voffB);
            PG8_BAR; PG8_WAIT_L(0); PG8_MMA(0, 1, At, B1); PG8_BAR;
            PG8_LDA(At, 0, 1); PG8_STAGE(PG8_SA(0, 0), a2, voffA);
            PG8_BAR; PG8_WAIT_L(0); PG8_MMA(1, 0, At, B0); PG8_BAR; PG8_SCHED;
            PG8_STAGE(PG8_SB(0, 1), b2 + hstep, voffB);
            PG8_WAIT_V(6); PG8_BAR; PG8_MMA(1, 1, At, B1); PG8_BAR;
            PG8_LDB(B0, 1, 0); PG8_SCHED; PG8_LDA(At, 1, 0); PG8_STAGE(PG8_SA(0, 1), a2 + hstep, voffA);
            PG8_WAIT_L(8); PG8_BAR; PG8_WAIT_L(0); PG8_MMA(0, 0, At, B0); PG8_BAR; PG8_SCHED;
            PG8_LDB(B1, 1, 1); PG8_STAGE(PG8_SB(1, 0), b3, voffB);
            PG8_BAR; PG8_WAIT_L(0); PG8_MMA(0, 1, At, B1); PG8_BAR;
            PG8_LDA(At, 1, 1); PG8_STAGE(PG8_SA(1, 0), a3, voffA);
            PG8_BAR; PG8_WAIT_L(0); PG8_MMA(1, 0, At, B0); PG8_BAR; PG8_SCHED;
            PG8_STAGE(PG8_SB(1, 1), b3 + hstep, voffB);
            PG8_WAIT_V(6); PG8_BAR; PG8_MMA(1, 1, At, B1); PG8_BAR;
            }
        }
        if constexpr (ALIGN_EPI) { if (wr == 0) PG8_BAR; }
        if constexpr (!Epi::AFTER_DRAIN) { E(acc, cur, wr, wc, fr, fq); S.done(cur); }
        if (!has_next) break;
#pragma unroll
        for (int a = 0; a < 2; ++a)
#pragma unroll
            for (int b = 0; b < 2; ++b)
#pragma unroll
                for (int m = 0; m < 4; ++m)
#pragma unroll
                    for (int n = 0; n < 2; ++n) acc[a][b][m][n] = (f32x4){0.f, 0.f, 0.f, 0.f};
        cur = nxt; cA = nA; cB = nB; ++ui;
        if constexpr (ALIGN_EPI) { if (wr == 1) PG8_BAR; }
    }
    PG8_WAIT_V(0);
    if constexpr (!ALIGN_EPI) { if (wr == 0) PG8_BAR; }
    PG8_BAR;
    if constexpr (Epi::AFTER_DRAIN) { E.fused(acc, cur, wr, wc, fr, fq, lds, wid, lane); S.done(cur); }
#undef PG8_SA
#undef PG8_SB
#undef PG8_STAGE
#undef PG8_LDA
#undef PG8_LDB
#undef PG8_MMA
#undef PG8_WAIT_V
#undef PG8_WAIT_L
#undef PG8_BAR
#undef PG8_SCHED
}
}
#define XB_TMO      128
#define XB_XCNT(j)  (256  + 64 * (j))
#define XB_XSUB(j)  (1280 + 64 * (j))
#define XB_XGEN(j)  (2304 + 64 * (j))
#define XB_TOP      3328
#define XB_TOPGEN   3392
#define XCD_BAR_WORDS 3456
#define XB_SPIN_CAP (1u << 18)

__device__ __forceinline__ unsigned xb_ld(unsigned* p)              { return __hip_atomic_load(p, __ATOMIC_RELAXED, __HIP_MEMORY_SCOPE_AGENT); }
__device__ __forceinline__ unsigned xb_add(unsigned* p, unsigned v) { return __hip_atomic_fetch_add(p, v, __ATOMIC_RELAXED, __HIP_MEMORY_SCOPE_AGENT); }
__device__ __forceinline__ unsigned xb_xcc_id() { return (unsigned)__builtin_amdgcn_s_getreg((3 << 11) | 20) & 0xFu; }
#define XB_SPIN(cond, bar) do { unsigned _sp = 0; while (cond) { __builtin_amdgcn_s_sleep(1); \
    if ((++_sp & 255u) == 0u) { if (xb_ld(&(bar)[XB_TMO])) break; if (_sp > XB_SPIN_CAP) { atomicAdd(&(bar)[XB_TMO], 1u); break; } } } } while (0)

struct XcdBarrier {
    unsigned* bar; unsigned x; unsigned w0;
    volatile LAS unsigned* st;
};

__device__ __forceinline__ XcdBarrier xcd_barrier_post(unsigned* bar, volatile LAS unsigned* st) {
    XcdBarrier b; b.bar = bar; b.x = xb_xcc_id(); b.st = st; b.w0 = 0u;
    if (threadIdx.x == 0) (void)xb_add(&bar[XB_XCNT(b.x)], 1u);
    return b;
}
__device__ __forceinline__ void xcd_barrier_complete(unsigned* bar, unsigned x, unsigned& nloc, unsigned& nx) {
    const unsigned G = gridDim.x * gridDim.y * gridDim.z;
    unsigned sum, cnt, mine, sp = 0u;
    for (;;) {
        sum = 0u; cnt = 0u; mine = 0u;
#pragma unroll
        for (unsigned j = 0; j < 16; ++j) { const unsigned c = xb_ld(&bar[XB_XCNT(j)]); sum += c; cnt += (c > 0u) ? 1u : 0u; mine = (j == x) ? c : mine; }
        if (sum == G) break;
        __builtin_amdgcn_s_sleep(1);
        if ((++sp & 255u) == 0u) { if (xb_ld(&bar[XB_TMO])) break; if (sp > XB_SPIN_CAP) { atomicAdd(&bar[XB_TMO], 1u); break; } }
    }
    nloc = mine > 0u ? mine : 1u; nx = cnt > 0u ? cnt : 1u;
}

__device__ __forceinline__ void xcd_barrier(const XcdBarrier& b) {
    asm volatile("s_waitcnt vmcnt(0)" ::: "memory");
    __syncthreads();
    if (b.w0 != 0u && lane_id() == 0) {
        unsigned* bar = b.bar;
        __builtin_amdgcn_s_waitcnt(0);
        unsigned nloc = b.st[0], nx = b.st[1];
        if (nloc == 0u) { xcd_barrier_complete(bar, b.x, nloc, nx); b.st[0] = nloc; b.st[1] = nx; }
        const unsigned old = xb_add(&bar[XB_XSUB(b.x)], 1u);
        const unsigned gen = old / nloc;
        if (old + 1u == (gen + 1u) * nloc) {
            __builtin_amdgcn_fence(__ATOMIC_RELEASE, "agent");
            asm volatile("s_waitcnt vmcnt(0)" ::: "memory");
            const unsigned og = xb_add(&bar[XB_TOP], 1u);
            const unsigned tg = og / nx;
            if (og + 1u == (tg + 1u) * nx) xb_add(&bar[XB_TOPGEN], 1u);
            else XB_SPIN(xb_ld(&bar[XB_TOPGEN]) == tg, bar);
            __builtin_amdgcn_fence(__ATOMIC_ACQUIRE, "agent");
            xb_add(&bar[XB_XGEN(b.x)], 1u);
            asm volatile("s_waitcnt vmcnt(0)" ::: "memory");
        } else {
            XB_SPIN(xb_ld(&bar[XB_XGEN(b.x)]) == gen, bar);
            __builtin_amdgcn_fence(__ATOMIC_ACQUIRE, "agent");
            asm volatile("s_waitcnt vmcnt(0)" ::: "memory");
        }
    }
    __syncthreads();
}

struct Frame {
    LAS unsigned char* lds;
    volatile LAS unsigned* MISC;
    gu32* ctl;
    int wave, vcu, G;
    unsigned char* ws;
};
#ifdef PROBE_LO
struct Params { const float* in[25]; float* out; unsigned char* ws; int ph_lo, ph_hi; int rerun, rsv; };
#define RCOEF(c) (kargs()->rerun ? 0.f : (c))
#else
struct Params { const float* in[25]; float* out; unsigned char* ws; int ph_lo, ph_hi; };
#define RCOEF(c) (c)
#endif
__device__ __forceinline__ const CAS Params* kargs() { const CAS Params* q = (const CAS Params*)__builtin_amdgcn_kernarg_segment_ptr(); asm volatile("" : "+s"(q)); return q; }
#define KIN(i) ((const float*)kargs()->in[i])
enum { I_X = 0, I_C, I_T5, I_ADAW, I_ADAB, I_NORMG, I_FWI, I_FWO, I_WIN, I_CKVG, I_WUK, I_WUV, I_MU, I_W0, I_W2, I_A0, I_A2, I_G2, I_KK, I_KA, I_RK, I_LNW, I_LNB, I_WOUT, I_FNG };

template <class Map>
__device__ __forceinline__ void conv_load(float (&v)[32], int it, int nblk, const float* src, int ld_src, int Ks, const Map& map, int lane_) {
    const int kb = it / nblk, nb = it % nblk; float sc = 1.f; const int scol = map(32 * nb + (lane_ & 31), sc);
    const unsigned loff = (unsigned)((lane_ >> 5) * ld_src + (scol < 0 ? 0 : scol));
#pragma unroll
    for (int i = 0; i < 32; ++i) { const int ku = 64 * kb + 2 * i; const int kc = ku < Ks ? ku : Ks - 2; v[i] = (src + (size_t)kc * ld_src)[loff]; }
}
template <class Map>
__device__ __forceinline__ void conv_proc(const float (&v)[32], int it, int nblk, int Ks, LAS float* scr, bf16* dst, int ldd, const Map& map, int lane_) {
    const int kb = it / nblk, nb = it % nblk, k0 = 64 * kb, n0 = 32 * nb; float sc = 1.f; const int scol = map(n0 + (lane_ & 31), sc); if (scol < 0) sc = 0.f;
#pragma unroll
    for (int i = 0; i < 32; ++i) scr[(2 * i + (lane_ >> 5)) * 33 + (lane_ & 31)] = v[i] * ((k0 + 2 * i < Ks) ? sc : 0.f);
    LDS_WAIT(); asm volatile("" ::: "memory");
    const int c = lane_ & 7;
#pragma unroll
    for (int j = 0; j < 4; ++j) { const int n = (lane_ >> 3) + 8 * j; const LAS float* s = scr + (8 * c) * 33 + n;
        v4u o; o.x = pk2(s[0 * 33], s[1 * 33]); o.y = pk2(s[2 * 33], s[3 * 33]); o.z = pk2(s[4 * 33], s[5 * 33]); o.w = pk2(s[6 * 33], s[7 * 33]);
        *(GAS v4u*)(dst + (size_t)(n0 + n) * ldd + k0 + 8 * c) = o; }
    LDS_WAIT(); asm volatile("" ::: "memory");
}
template <class Map>
__device__ __forceinline__ void convT(const Frame& F, const float* src, int ld_src, int Ks, int Kd, bf16* dst, int Nd, int ldd, const Map map, int& rot) {
    const int lane_ = lane_id();
    LAS float* scr = (LAS float*)(F.lds + F.wave * 16384);
    const int NGW = F.G * NWAVES; int gw = F.vcu * NWAVES + F.wave - rot; if (gw < 0) gw += NGW;
    const int nblk = Nd / 32, nitems = (Kd / 64) * nblk;
    rot = (rot + nitems) % NGW;
    float va[32], vb[32];
    if (gw < nitems) conv_load(va, gw, nblk, src, ld_src, Ks, map, lane_);
    for (int it = gw; it < nitems; it += 2 * NGW) {
        const int i1 = it + NGW, i2 = i1 + NGW;
        if (i1 < nitems) conv_load(vb, i1, nblk, src, ld_src, Ks, map, lane_);
        conv_proc(va, it, nblk, Ks, scr, dst, ldd, map, lane_);
        if (i2 < nitems) conv_load(va, i2, nblk, src, ld_src, Ks, map, lane_);
        if (i1 < nitems) conv_proc(vb, i1, nblk, Ks, scr, dst, ldd, map, lane_);
    }
}
struct MapId { __device__ __forceinline__ int operator()(int n, float&) const { return n; } };
struct MapFfnIn { __device__ __forceinline__ int operator()(int n, float&) const { return ((n & 128) ? FF : 0) + (n >> 8) * 128 + (n & 127); } };
struct MapWin {
    __device__ __forceinline__ int operator()(int n, float& sc) const { const int zc = 2048 + n;
        if (zc < ZC_WL) { if (zc >= ZC_WIDX) sc = 0.03125f; return zc - 2048 + 1024; }
        if (zc < 3856) return 5456 + (zc - ZC_WL);
        if (zc < ZC_R) return -1;
        return 2384 + (zc - ZC_R); } };

__device__ __forceinline__ void p0a_prologue(Frame& F) {
    const int tid_ = wtid(F.wave), lane_ = tid_ & 63;
    const int gw = F.vcu * NWAVES + F.wave, NGW = F.G * NWAVES;
    const size_t gt = (size_t)gw * 64 + lane_, NGT = (size_t)NGW * 64;
    unsigned char* ws = F.ws;
    {
        LAS float* cact = (LAS float*)F.lds;
        LAS float* red = (LAS float*)(F.lds + 32768);
        for (int i = tid_; i < BATCH * D; i += NTHR) { const float cv = KIN(I_C)[i]; cact[i] = cv / (1.0f + __expf(-cv)); }
        __syncthreads();
        float* mod = (float*)(ws + WS_MOD);
        const int ntask = DEPTH * (NMOD / 128);
        for (int task = F.vcu; task < ntask; task += F.G) {
            const int l = task / (NMOD / 128), c0 = (task % (NMOD / 128)) * 128;
            const float* W = KIN(I_ADAW) + (size_t)l * D * NMOD + c0 + 4 * (lane_ & 31);
            f32x4 a[4] = {{0.f, 0.f, 0.f, 0.f}, {0.f, 0.f, 0.f, 0.f}, {0.f, 0.f, 0.f, 0.f}, {0.f, 0.f, 0.f, 0.f}};
            const int kbase = F.wave * 256 + (lane_ >> 5);
#pragma unroll 16
            for (int i = 0; i < 128; ++i) { const int k = kbase + 2 * i; const f32x4 w = *(const GAS f32x4*)(W + (size_t)k * NMOD);
#pragma unroll
                for (int b = 0; b < 4; ++b) a[b] += w * cact[b * D + k]; }
#pragma unroll
            for (int b = 0; b < 4; ++b) {
#pragma unroll
                for (int j = 0; j < 4; ++j) a[b][j] += __shfl_xor(a[b][j], 32);
                if (lane_ < 32) *(LAS f32x4*)(red + (F.wave * 4 + b) * 128 + 4 * lane_) = a[b]; }
            __syncthreads();
            { const int b = tid_ >> 7, c = tid_ & 127; float s = 0.f;
#pragma unroll
              for (int w = 0; w < 8; ++w) s += red[(w * 4 + b) * 128 + c];
              mod[((size_t)l * BATCH + b) * NMOD + c0 + c] = s + KIN(I_ADAB)[(size_t)l * NMOD + c0 + c]; }
            __syncthreads();
        }
        __syncthreads();
    }
    int rot = 0;
    for (int li = 0; li < 2 * DEPTH; ++li) {
        convT(F, KIN(I_FWI) + (size_t)li * D * NFI, NFI, D, D, (bf16*)(ws + WS_WFI + li * WFI_ONE), NFI, D, MapFfnIn(), rot);
        convT(F, KIN(I_FWO) + (size_t)li * FF * D, D, FF, FF, (bf16*)(ws + WS_WFO + li * WFO_ONE), D, FF, MapId(), rot);
    }
    for (int l = 0; l < DEPTH; ++l) {
        convT(F, KIN(I_WIN) + (size_t)l * D * PIN, PIN, D, D, (bf16*)(ws + WS_WIN + l * WIN_ONE) + (size_t)2048 * D, NZ - 2048, D, MapWin(), rot);
        convT(F, KIN(I_WOUT) + (size_t)l * D * D + (size_t)1024 * D, D, 1024, 1024, (bf16*)(ws + WS_WOUT + l * WOUT_ONE) + 2048, D, KO, MapId(), rot);
        convT(F, KIN(I_WOUT) + (size_t)l * D * D, D, 1024, 1024, (bf16*)(ws + WS_WOUTTA + l * 4 * MiB), D, 1024, MapId(), rot);
        convT(F, KIN(I_W2) + (size_t)l * 96 * 1024, 1024, 96, 256, (bf16*)(ws + WS_WLORA + (l * 3 + 0) * WLORA_ONE), 1024, 256, MapId(), rot);
        convT(F, KIN(I_A2) + (size_t)l * 96 * 1024, 1024, 96, 256, (bf16*)(ws + WS_WLORA + (l * 3 + 1) * WLORA_ONE), 1024, 256, MapId(), rot);
        convT(F, KIN(I_G2) + (size_t)l * 256 * 1024, 1024, 256, 256, (bf16*)(ws + WS_WLORA + (l * 3 + 2) * WLORA_ONE), 1024, 256, MapId(), rot);
        const float* win = KIN(I_WIN) + (size_t)l * D * PIN; bf16* winq = (bf16*)(ws + WS_WINQ + l * 4 * MiB);
        const float* wuk = KIN(I_WUK) + (size_t)l * 256 * 1024; const float* wuv = KIN(I_WUV) + (size_t)l * 256 * 1024;
        bf16* bduk = (bf16*)(ws + WS_BDUK + l * 4 * MiB); bf16* bduv = (bf16*)(ws + WS_BDUV + l * 4 * MiB);
        for (size_t e = gt; e < (size_t)2048 * 128; e += NGT) {
            const int row = (int)(e >> 7), c8 = (int)(e & 127) * 8;
            { const float* s = win + (size_t)row * PIN + c8; const f32x4 a = *(const GAS f32x4*)s, b = *(const GAS f32x4*)(s + 4);
              v4u o; o.x = pk2(a.x, a.y); o.y = pk2(a.z, a.w); o.z = pk2(b.x, b.y); o.w = pk2(b.z, b.w); *(GAS v4u*)(winq + (size_t)row * 1024 + c8) = o; }
            const int h = row >> 8, r = row & 255, hp = c8 >> 7;
            v4u ok = {0u, 0u, 0u, 0u}, ov = {0u, 0u, 0u, 0u};
            if (h == hp) { const float qs = 0.08838834764831845f;
                const float* s = wuk + (size_t)r * 1024 + c8; const f32x4 a = *(const GAS f32x4*)s * qs, b = *(const GAS f32x4*)(s + 4) * qs;
                ok.x = pk2(a.x, a.y); ok.y = pk2(a.z, a.w); ok.z = pk2(b.x, b.y); ok.w = pk2(b.z, b.w);
                const float* t = wuv + (size_t)r * 1024 + c8; const f32x4 c = *(const GAS f32x4*)t, d = *(const GAS f32x4*)(t + 4);
                ov.x = pk2(c.x, c.y); ov.y = pk2(c.z, c.w); ov.z = pk2(d.x, d.y); ov.w = pk2(d.z, d.w); }
            *(GAS v4u*)(bduk + (size_t)row * 1024 + c8) = ok; *(GAS v4u*)(bduv + (size_t)row * 1024 + c8) = ov;
        }
    }
}

__device__ __forceinline__ float row_sumsq(const f32x4 (&v)[8]) { float s = 0.f;
#pragma unroll
    for (int j = 0; j < 8; ++j) s += (v[j].x * v[j].x + v[j].y * v[j].y) + (v[j].z * v[j].z + v[j].w * v[j].w);
    return wave_sum(s); }
__device__ __forceinline__ void adaln_phase(const Frame& F, const float* h, const float* g, const float* modl  , int sub, bf16* hn) {
    const int lane_ = lane_id();
    const int gw = F.vcu * NWAVES + F.wave, NGW = F.G * NWAVES;
    for (int grp = gw; grp < M / 8; grp += NGW) {
        const int m0 = grp * 8, b = m0 >> 12;
        const float* sh = modl + (size_t)b * NMOD + (sub * 3 + 0) * D; const float* scl = sh + D;
        f32x4 ga[8], sb[8];
#pragma unroll
        for (int j = 0; j < 8; ++j) { const int c = 4 * lane_ + 256 * j; ga[j] = *(const GAS f32x4*)(g + c) * (*(const GAS f32x4*)(scl + c) + 1.0f); sb[j] = *(const GAS f32x4*)(sh + c); }
        const GAS f32x4* xr = (const GAS f32x4*)(h + (size_t)m0 * D) + lane_; GAS v2u* o8 = (GAS v2u*)(hn + (size_t)m0 * D) + lane_;
        f32x4 va[8], vb[8];
#define AL_LOAD(v, r) { _Pragma("unroll") for (int j = 0; j < 8; ++j) v[j] = xr[(size_t)(r) * (D / 4) + 64 * j]; }
#define AL_PROC(v, r) { const float rstd = 1.0f / sqrtf(row_sumsq(v) * (1.0f / D) + RMS_EPS); \
            _Pragma("unroll") for (int j = 0; j < 8; ++j) { const f32x4 y = v[j] * rstd * ga[j] + sb[j]; v2u o; o.x = pk2(y.x, y.y); o.y = pk2(y.z, y.w); o8[(size_t)(r) * (D / 4) + 64 * j] = o; } }
        AL_LOAD(va, 0)
#pragma unroll 1
        for (int r = 0; r < 8; r += 2) { AL_LOAD(vb, r + 1) AL_PROC(va, r) if (r + 2 < 8) AL_LOAD(va, r + 2) AL_PROC(vb, r + 1) }
#undef AL_LOAD
#undef AL_PROC
    }
}

__device__ __forceinline__ void final_norm_phase(const Frame& F, float* out, const float* g) {
    const int lane_ = lane_id();
    const int gw = F.vcu * NWAVES + F.wave, NGW = F.G * NWAVES;
    for (int grp = gw; grp < M / 8; grp += NGW) {
        f32x4 gg[8];
#pragma unroll
        for (int j = 0; j < 8; ++j) gg[j] = *(const GAS f32x4*)(g + 4 * lane_ + 256 * j);
        GAS f32x4* xr = (GAS f32x4*)(out + (size_t)grp * 8 * D) + lane_;
        f32x4 va[8], vb[8];
#define FN_LOAD(v, r) { _Pragma("unroll") for (int j = 0; j < 8; ++j) v[j] = xr[(size_t)(r) * (D / 4) + 64 * j]; }
#define FN_PROC(v, r) { const float rstd = 1.0f / sqrtf(row_sumsq(v) * (1.0f / D) + RMS_EPS); \
            _Pragma("unroll") for (int j = 0; j < 8; ++j) xr[(size_t)(r) * (D / 4) + 64 * j] = v[j] * rstd * gg[j]; }
        FN_LOAD(va, 0)
#pragma unroll 1
        for (int r = 0; r < 8; r += 2) { FN_LOAD(vb, r + 1) FN_PROC(va, r) if (r + 2 < 8) FN_LOAD(va, r + 2) FN_PROC(vb, r + 1) }
#undef FN_LOAD
#undef FN_PROC
    }
}

__device__ __forceinline__ float row_sumsq_h(const v4u (&v)[4]) { float s = 0.f;
#pragma unroll
    for (int j = 0; j < 4; ++j) { float x[8]; x[0] = bflo(v[j].x); x[1] = bfhi(v[j].x); x[2] = bflo(v[j].y); x[3] = bfhi(v[j].y); x[4] = bflo(v[j].z); x[5] = bfhi(v[j].z); x[6] = bflo(v[j].w); x[7] = bfhi(v[j].w);
        s += ((x[0] * x[0] + x[1] * x[1]) + (x[2] * x[2] + x[3] * x[3])) + ((x[4] * x[4] + x[5] * x[5]) + (x[6] * x[6] + x[7] * x[7])); }
    return wave_sum(s); }
__device__ __forceinline__ void adaln_phase_h(const Frame& F, const bf16* h, const float* g, const float* modl  , int sub, bf16* hn) {
    const int lane_ = lane_id();
    const int gw = F.vcu * NWAVES + F.wave, NGW = F.G * NWAVES;
    for (int grp = gw; grp < M / 8; grp += NGW) {
        const int m0 = grp * 8, b = m0 >> 12;
        const float* sh = modl + (size_t)b * NMOD + (sub * 3 + 0) * D; const float* scl = sh + D;
        const GAS v4u* xr = (const GAS v4u*)(h + (size_t)m0 * D) + lane_; GAS v4u* o8 = (GAS v4u*)(hn + (size_t)m0 * D) + lane_;
        v4u va[4][4], vb[4][4];
#pragma unroll
        for (int r = 0; r < 4; ++r)
#pragma unroll
            for (int j = 0; j < 4; ++j) va[r][j] = xr[(size_t)r * (D / 8) + 64 * j];
#pragma unroll
        for (int r = 0; r < 4; ++r)
#pragma unroll
            for (int j = 0; j < 4; ++j) vb[r][j] = xr[(size_t)(r + 4) * (D / 8) + 64 * j];
        f32x4 ga[4][2], sb[4][2];
#pragma unroll
        for (int j = 0; j < 4; ++j)
#pragma unroll
            for (int n = 0; n < 2; ++n) { const int c = 8 * lane_ + 512 * j + 4 * n; ga[j][n] = *(const GAS f32x4*)(g + c) * (*(const GAS f32x4*)(scl + c) + 1.0f); sb[j][n] = *(const GAS f32x4*)(sh + c); }
#define ALH_PROC(v, r) { const float rstd = 1.0f / sqrtf(row_sumsq_h(v) * (1.0f / D) + RMS_EPS); \
            _Pragma("unroll") for (int j = 0; j < 4; ++j) { const v4u w = v[j]; \
                const f32x4 x0 = {bflo(w.x), bfhi(w.x), bflo(w.y), bfhi(w.y)}, x1 = {bflo(w.z), bfhi(w.z), bflo(w.w), bfhi(w.w)}; \
                const f32x4 y0 = x0 * rstd * ga[j][0] + sb[j][0], y1 = x1 * rstd * ga[j][1] + sb[j][1]; \
                v4u o; o.x = pk2(y0.x, y0.y); o.y = pk2(y0.z, y0.w); o.z = pk2(y1.x, y1.y); o.w = pk2(y1.z, y1.w); o8[(size_t)(r) * (D / 8) + 64 * j] = o; } }
#pragma unroll
        for (int r = 0; r < 4; ++r) ALH_PROC(va[r], r)
#pragma unroll
        for (int r = 0; r < 4; ++r) ALH_PROC(vb[r], r + 4)
#undef ALH_PROC
    }
}
__device__ __forceinline__ void final_norm_phase_h(const Frame& F, const bf16* h, float* out, const float* g) {
    const int lane_ = lane_id();
    const int gw = F.vcu * NWAVES + F.wave, NGW = F.G * NWAVES;
    for (int grp = gw; grp < M / 8; grp += NGW) {
        const GAS v4u* xr = (const GAS v4u*)(h + (size_t)grp * 8 * D) + lane_; GAS f32x4* orow = (GAS f32x4*)(out + (size_t)grp * 8 * D) + 2 * lane_;
        v4u va[4][4], vb[4][4];
#pragma unroll
        for (int r = 0; r < 4; ++r)
#pragma unroll
            for (int j = 0; j < 4; ++j) va[r][j] = xr[(size_t)r * (D / 8) + 64 * j];
#pragma unroll
        for (int r = 0; r < 4; ++r)
#pragma unroll
            for (int j = 0; j < 4; ++j) vb[r][j] = xr[(size_t)(r + 4) * (D / 8) + 64 * j];
        f32x4 gg[4][2];
#pragma unroll
        for (int j = 0; j < 4; ++j)
#pragma unroll
            for (int n = 0; n < 2; ++n) gg[j][n] = *(const GAS f32x4*)(g + 8 * lane_ + 512 * j + 4 * n);
#define FNH_PROC(v, r) { const float rstd = 1.0f / sqrtf(row_sumsq_h(v) * (1.0f / D) + RMS_EPS); \
            _Pragma("unroll") for (int j = 0; j < 4; ++j) { const v4u w = v[j]; \
                const f32x4 x0 = {bflo(w.x), bfhi(w.x), bflo(w.y), bfhi(w.y)}, x1 = {bflo(w.z), bfhi(w.z), bflo(w.w), bfhi(w.w)}; \
                orow[(size_t)(r) * (D / 4) + 128 * j] = x0 * rstd * gg[j][0]; orow[(size_t)(r) * (D / 4) + 128 * j + 1] = x1 * rstd * gg[j][1]; } }
#pragma unroll
        for (int r = 0; r < 4; ++r) FNH_PROC(va[r], r)
#pragma unroll
        for (int r = 0; r < 4; ++r) FNH_PROC(vb[r], r + 4)
#undef FNH_PROC
    }
}

__device__ __forceinline__ void unpack8(const v4u w, float (&x)[8]) { x[0] = bflo(w.x); x[1] = bfhi(w.x); x[2] = bflo(w.y); x[3] = bfhi(w.y); x[4] = bflo(w.z); x[5] = bfhi(w.z); x[6] = bflo(w.w); x[7] = bfhi(w.w); }
__device__ __forceinline__ v4u pack8(const float (&x)[8]) { v4u o; o.x = pk2(x[0], x[1]); o.y = pk2(x[2], x[3]); o.z = pk2(x[4], x[5]); o.w = pk2(x[6], x[7]); return o; }

__device__ __forceinline__ void prep_phase(const Frame& F, const bf16* __restrict__ Z, const float* __restrict__ mu, const float* __restrict__ ckvg, bf16* __restrict__ LA, bf16* __restrict__ CKV) {
    const int gw = F.vcu * NWAVES + F.wave, NGW = F.G * NWAVES, lane = lane_id();
    const int l5 = lane & 31, j0 = 8 * l5, hf = lane >> 5;
    for (int grp = gw; grp < M / 8; grp += NGW) {
        const int r0 = grp * 8 + 4 * hf;
        const bool hp = (r0 & (SEQ - 1)) != 0;
        const bf16* zb = Z + (size_t)r0 * NZ;
        v4u zw[3][5], cw[4];
#pragma unroll
        for (int which = 0; which < 3; ++which) {
            const int zcol = which == 0 ? ZC_WL : (which == 1 ? ZC_AL : ZC_GL), nval = which == 2 ? 256 : 96;
#pragma unroll
            for (int i = 0; i < 5; ++i) { zw[which][i] = (v4u){0u, 0u, 0u, 0u}; if (j0 < nval && (i > 0 || hp)) zw[which][i] = *(const GAS v4u*)(zb + (ptrdiff_t)(i - 1) * NZ + zcol + j0); } }
#pragma unroll
        for (int i = 0; i < 4; ++i) cw[i] = *(const GAS v4u*)(zb + (size_t)i * NZ + ZC_CKV + j0);
#pragma unroll
        for (int which = 0; which < 3; ++which) {
            const int moff = which == 0 ? 3072 : (which == 1 ? 3168 : 3264), nval = which == 2 ? 256 : 96;
            float mv[8];
#pragma unroll
            for (int j = 0; j < 8; ++j) mv[j] = (j0 < nval) ? mu[moff + j0 + j] : 0.f;
#pragma unroll
            for (int i = 0; i < 4; ++i) {
                float y[8] = {0.f, 0.f, 0.f, 0.f, 0.f, 0.f, 0.f, 0.f};
                if (j0 < nval) { float cc[8], pp[8]; unpack8(zw[which][i + 1], cc); unpack8(zw[which][i], pp);
#pragma unroll
                    for (int j = 0; j < 8; ++j) { const float zm = cc[j] + (pp[j] - cc[j]) * mv[j];
                        if (which == 0) { const float e = __expf(-2.0f * fabsf(zm)); const float th = (1.0f - e) / (1.0f + e); y[j] = zm < 0.f ? -th : th; }
                        else if (which == 1) y[j] = zm;
                        else y[j] = 1.0f / (1.0f + __expf(-zm)); } }
                *(GAS v4u*)(LA + (size_t)which * M * 256 + (size_t)(r0 + i) * 256 + j0) = pack8(y); }
        }
        {
            float gv[8];
#pragma unroll
            for (int j = 0; j < 8; ++j) gv[j] = ckvg[j0 + j];
#pragma unroll
            for (int i = 0; i < 4; ++i) { float cc[8]; unpack8(cw[i], cc);
                float ss = 0.f;
#pragma unroll
                for (int j = 0; j < 8; ++j) ss += cc[j] * cc[j];
#pragma unroll
                for (int o = 1; o < 32; o <<= 1) ss += __shfl_xor(ss, o);
                const float rstd = 1.0f / sqrtf(ss * (1.0f / 256.0f) + RMS_EPS);
                float y[8];
#pragma unroll
                for (int j = 0; j < 8; ++j) y[j] = cc[j] * rstd * gv[j];
                *(GAS v4u*)(CKV + (size_t)(r0 + i) * 256 + j0) = pack8(y); }
        }
    }
}

__device__ __forceinline__ float wave_sum_f(float x) {
    x += __builtin_bit_cast(float, __builtin_amdgcn_update_dpp(0, __builtin_bit_cast(int, x), 0xB1, 0xF, 0xF, true));
    x += __builtin_bit_cast(float, __builtin_amdgcn_update_dpp(0, __builtin_bit_cast(int, x), 0x4E, 0xF, 0xF, true));
    x += __builtin_bit_cast(float, __builtin_amdgcn_update_dpp(0, __builtin_bit_cast(int, x), 0x141, 0xF, 0xF, true));
    x += __builtin_bit_cast(float, __builtin_amdgcn_update_dpp(0, __builtin_bit_cast(int, x), 0x140, 0xF, 0xF, true));
    const int xi = __builtin_bit_cast(int, x);
    return (__builtin_bit_cast(float, __builtin_amdgcn_readlane(xi, 0)) + __builtin_bit_cast(float, __builtin_amdgcn_readlane(xi, 16))) +
           (__builtin_bit_cast(float, __builtin_amdgcn_readlane(xi, 32)) + __builtin_bit_cast(float, __builtin_amdgcn_readlane(xi, 48)));
}
__device__ __forceinline__ unsigned wave_sum_u(unsigned x) {
    x += (unsigned)__builtin_amdgcn_update_dpp(0, (int)x, 0xB1, 0xF, 0xF, true);
    x += (unsigned)__builtin_amdgcn_update_dpp(0, (int)x, 0x4E, 0xF, 0xF, true);
    x += (unsigned)__builtin_amdgcn_update_dpp(0, (int)x, 0x141, 0xF, 0xF, true);
    x += (unsigned)__builtin_amdgcn_update_dpp(0, (int)x, 0x140, 0xF, 0xF, true);
    return (unsigned)__builtin_amdgcn_readlane((int)x, 0) + (unsigned)__builtin_amdgcn_readlane((int)x, 16) + (unsigned)__builtin_amdgcn_readlane((int)x, 32) + (unsigned)__builtin_amdgcn_readlane((int)x, 48);
}
__device__ __forceinline__ unsigned wave_incl_scan(unsigned x) {
    x += (unsigned)__builtin_amdgcn_update_dpp(0, (int)x, 0x111, 0xF, 0xF, false);
    x += (unsigned)__builtin_amdgcn_update_dpp(0, (int)x, 0x112, 0xF, 0xF, false);
    x += (unsigned)__builtin_amdgcn_update_dpp(0, (int)x, 0x114, 0xF, 0xF, false);
    x += (unsigned)__builtin_amdgcn_update_dpp(0, (int)x, 0x118, 0xF, 0xF, false);
    x += (unsigned)__builtin_amdgcn_update_dpp(0, (int)x, 0x142, 0xA, 0xF, false);
    x += (unsigned)__builtin_amdgcn_update_dpp(0, (int)x, 0x143, 0xC, 0xF, false);
    return x;
}
__device__ __forceinline__ unsigned fkey(float f) { const unsigned u = __builtin_bit_cast(unsigned, f); return (u & 0x80000000u) ? ~u : (u | 0x80000000u); }
template <int REP_SC, int REP_SEL>
__device__ __forceinline__ void topk_phase(const Frame& F, const bf16* __restrict__ Z, unsigned short* __restrict__ IDX) {
    LAS float* SC = (LAS float*)F.lds;
    const int lane = lane_id(), w = F.wave, hl = lane >> 5, ln = lane & 31;
    const int qq = (ln >> 2) & 1, hh = (ln & 3) + 4 * (ln >> 3);
    const unsigned long long lt_mask = (1ull << lane) - 1ull;
    bf16x8 A[4][4]; v4u wp[4][2];
#define TK_LOAD_Q(m0_) { _Pragma("unroll") for (int mt = 0; mt < 4; ++mt) { \
            _Pragma("unroll") for (int ks = 0; ks < 4; ++ks) A[mt][ks] = *(const GAS bf16x8*)(Z + (size_t)((m0_) + 2 * mt + qq) * NZ + ZC_QIDX + hh * 64 + 16 * ks + 8 * hl); } }
    if (F.vcu < M / 8) TK_LOAD_Q(F.vcu * 8)
    for (int ui = 0; ui * F.G < M / 8; ++ui) {
        const int unit = ui * F.G + ((ui & 1) ? (F.G - 1 - F.vcu) : F.vcu);
        if (unit >= M / 8) break;
        const int m0 = unit * 8, t0 = m0 & (SEQ - 1);
        const bf16* Zb = Z + (size_t)(m0 - t0) * NZ;
#pragma unroll
        for (int mt = 0; mt < 4; ++mt) { wp[mt][0] = *(const GAS v4u*)(Z + (size_t)(m0 + 2 * mt + hl) * NZ + ZC_WIDX); wp[mt][1] = *(const GAS v4u*)(Z + (size_t)(m0 + 2 * mt + hl) * NZ + ZC_WIDX + 8); }
        const int nkt = (t0 + 7) / 32 + 1;
        for (int rep_sc = 0; rep_sc < REP_SC; ++rep_sc) {
            const bool extra = rep_sc > 0;
            constexpr bool X_NOLOAD = (REPK == 63 || REPK == 66), X_NOMMA = (REPK == 64 || REPK == 65), X_NOEPI = (REPK == 65);
            bf16x8 Bn[4];
            if (w < nkt) { const bf16* kp = Zb + (size_t)(w * 32 + ln) * NZ + ZC_KIDX + 8 * hl;
#pragma unroll
                for (int ks = 0; ks < 4; ++ks) Bn[ks] = *(const GAS bf16x8*)(kp + 16 * ks); }
            unsigned sink = 0u;
            for (int kt = w; kt < nkt; kt += NWAVES) {
                bf16x8 Bf[4];
#pragma unroll
                for (int ks = 0; ks < 4; ++ks) Bf[ks] = Bn[ks];
                if (kt + NWAVES < nkt && !(extra && X_NOLOAD)) { const bf16* kp = Zb + (size_t)((kt + NWAVES) * 32 + ln) * NZ + ZC_KIDX + 8 * hl;
#pragma unroll
                    for (int ks = 0; ks < 4; ++ks) Bn[ks] = *(const GAS bf16x8*)(kp + 16 * ks); }
                if (extra && X_NOEPI) {
#pragma unroll
                    for (int ks = 0; ks < 4; ++ks) sink ^= (unsigned)Bf[ks][0];
                    continue; }
                if (extra && REPK == 66) {
                    unsigned xs[8];
#pragma unroll
                    for (int i = 0; i < 8; ++i) xs[i] = (unsigned)Bf[i & 3][i >> 2] + sink;
#pragma unroll
                    for (int r = 0; r < 32; ++r) {
#pragma unroll
                        for (int i = 0; i < 8; ++i) { xs[i] ^= (unsigned)kt; xs[i] += 0x9e3779b9u + (unsigned)lane; } }
#pragma unroll
                    for (int i = 0; i < 8; ++i) sink ^= xs[i];
                    continue; }
#pragma unroll
                for (int mt = 0; mt < 4; ++mt) {
                    f32x16 acc;
#pragma unroll
                    for (int i = 0; i < 16; ++i) acc[i] = 0.f;
                    if (!(extra && X_NOMMA)) {
#pragma unroll
                        for (int ks = 0; ks < 4; ++ks) acc = __builtin_amdgcn_mfma_f32_32x32x16_bf16(A[mt][ks], Bf[ks], acc, 0, 0, 0);
                    } else { acc[0] = __builtin_bit_cast(float, (unsigned)Bf[mt][1] << 16); acc[5] = __builtin_bit_cast(float, (unsigned)Bf[mt][2] << 16); }
                    float s = 0.f;
                    typedef short s16x2 __attribute__((ext_vector_type(2)));
#pragma unroll
                    for (int p2 = 0; p2 < 8; ++p2) { const unsigned pk = pk2(acc[2 * p2], acc[2 * p2 + 1]);
                        const s16x2 rl = __builtin_elementwise_max(__builtin_bit_cast(s16x2, pk), (s16x2){0, 0});
                        const unsigned wv = wp[mt][p2 >> 2][p2 & 3];
                        s = __builtin_amdgcn_fdot2_f32_bf16(__builtin_bit_cast(hwbf2, rl), __builtin_bit_cast(hwbf2, wv), s, false); }
                    if (extra && REPK != 61) ((LAS float*)(F.lds + 131072))[lane] = s; else SC[(2 * mt + hl) * SEQ + kt * 32 + ln] = s;
                }
            }
            if (extra && (X_NOEPI || REPK == 66)) ((LAS unsigned*)(F.lds + 131072))[lane] = sink;
        }
        __syncthreads();
        { const int un_ = (ui + 1) * F.G + (((ui + 1) & 1) ? (F.G - 1 - F.vcu) : F.vcu); if ((ui + 1) * F.G < M / 8 && un_ < M / 8) TK_LOAD_Q(un_ * 8) }
        for (int rep_sel = 0; rep_sel < REP_SEL; ++rep_sel)
        {
            const int m = m0 + w, nv = t0 + w + 1;
            unsigned u[64];
#pragma unroll
            for (int i = 0; i < 64; ++i) u[i] = __builtin_bit_cast(unsigned, SC[w * SEQ + lane + 64 * i]);
#pragma unroll
            for (int i = 0; i < 64; ++i) { const unsigned x = u[i]; const unsigned kx = (x & 0x80000000u) ? ~x : (x | 0x80000000u); u[i] = (lane + 64 * i < nv) ? (kx >> 1) : 0u; }
            unsigned T = 1u; int need_eq = 0;
            if (nv > TOPK) {
                T = 0u; bool exact = false;
                const int nreg = (nv > 3072) ? 64 : (nv > 2048 ? 48 : (nv > 1024 ? 32 : 16));
                for (int bit = 30; bit >= 0; --bit) {
                    const unsigned cand = T | (1u << bit); unsigned clt = 0u;
#pragma unroll
                    for (int g4 = 0; g4 < 4; ++g4) if (g4 * 1024 < nv) { unsigned acc = 0u;
#pragma unroll
                        for (int i = 16 * g4; i < 16 * g4 + 16; ++i) acc = __builtin_amdgcn_alignbit(acc, u[i] - cand, 31);
                        clt += (unsigned)__popc(acc); }
                    const int cnt = 64 * nreg - (int)wave_sum_u(clt);
                    if (cnt >= TOPK) { T = cand; if (cnt == TOPK) { exact = true; break; } }
                }
                if (exact) { T -= 1u; need_eq = 0; }
                else { unsigned c = 0u;
#pragma unroll
                    for (int i = 0; i < 64; ++i) c += (u[i] > T) ? 1u : 0u;
                    need_eq = TOPK - (int)wave_sum_u(c); }
            }
            LAS unsigned short* stage = (LAS unsigned short*)(SC + w * SEQ);
            int base = 0;
            if (need_eq == 0) {
#pragma unroll
                for (int g4 = 0; g4 < 4; ++g4) if (g4 * 1024 < nv) {
#pragma unroll
                    for (int i = 16 * g4; i < 16 * g4 + 16; ++i) {
                        const bool sel = u[i] > T; const unsigned long long ms = __ballot(sel);
                        const int pos = base + (int)__builtin_amdgcn_mbcnt_hi((unsigned)(ms >> 32), __builtin_amdgcn_mbcnt_lo((unsigned)ms, 0u));
                        if (sel) stage[pos] = (unsigned short)(lane + 64 * i);
                        base += __popcll(ms);
                    } }
            } else {
                int eqseen = 0;
#pragma unroll
                for (int g4 = 0; g4 < 4; ++g4) if (g4 * 1024 < nv) {
#pragma unroll
                    for (int i = 16 * g4; i < 16 * g4 + 16; ++i) {
                        const bool gt = u[i] > T, eq = (u[i] == T);
                        const unsigned long long meq = __ballot(eq);
                        const int eqr = eqseen + __popcll(meq & lt_mask);
                        const bool sel = gt || (eq && eqr < need_eq);
                        const unsigned long long ms = __ballot(sel);
                        const int pos = base + __popcll(ms & lt_mask);
                        if (sel && pos < TOPK) stage[pos] = (unsigned short)(lane + 64 * i);
                        base += __popcll(ms); eqseen += __popcll(meq);
                    } }
            }
            for (int p = base + lane; p < TOPK; p += 64) stage[p] = (unsigned short)0xFFFFu;
            LDS_WAIT();
            *(GAS v2u*)(IDX + (size_t)m * TOPK + 4 * lane) = *(const LAS v2u*)(stage + 4 * lane);
        }
        __syncthreads();
    }
}

#undef TK_LOAD_Q
template <int OFF> __device__ __forceinline__ bf16x4 tr_read4(unsigned lds_addr) { bf16x4 r; asm volatile("ds_read_b64_tr_b16 %0, %1 offset:%2\n\ts_waitcnt lgkmcnt(0)" : "=&v"(r) : "v"(lds_addr), "n"(OFF) : "memory"); return r; }
constexpr int AT_BP = 1056, AT_IDX = 16 * AT_BP, AT_TILE = AT_IDX + 1024, AT_TB = SCR_BYTES + 1024, AT_LUT = AT_TB + 1024;
static_assert(NWAVES * AT_TILE <= SCR_BYTES && AT_LUT + 132 <= LDS_BYTES && MISC_OFF + 128 <= AT_TB, "attention LDS");
__device__ __forceinline__ float xrow_max(float x) {
    const unsigned xi = __builtin_bit_cast(unsigned, x); const auto a = __builtin_amdgcn_permlane16_swap(xi, xi, false, false);
    const float m = fmaxf(__builtin_bit_cast(float, a[0]), __builtin_bit_cast(float, a[1])); const unsigned mi = __builtin_bit_cast(unsigned, m);
    const auto b = __builtin_amdgcn_permlane32_swap(mi, mi, false, false); return fmaxf(__builtin_bit_cast(float, b[0]), __builtin_bit_cast(float, b[1])); }
__device__ __forceinline__ float xrow_sum(float x) {
    const unsigned xi = __builtin_bit_cast(unsigned, x); const auto a = __builtin_amdgcn_permlane16_swap(xi, xi, false, false);
    const float m = __builtin_bit_cast(float, a[0]) + __builtin_bit_cast(float, a[1]); const unsigned mi = __builtin_bit_cast(unsigned, m);
    const auto b = __builtin_amdgcn_permlane32_swap(mi, mi, false, false); return __builtin_bit_cast(float, b[0]) + __builtin_bit_cast(float, b[1]); }
__device__ __forceinline__ void attn_setup(const Frame& F, const float* t5) {
    LAS float* tb = (LAS float*)(F.lds + AT_TB); LAS unsigned char* lut = F.lds + AT_LUT;
    for (int i = wtid(F.wave); i < 256; i += NTHR) tb[i] = t5[i];
    for (int n = wtid(F.wave); n < 132; n += NTHR) {
        int bk = n; if (n >= 16) { bk = 16 + (int)(__log2f((float)n * 0.0625f) * 5.33333333f); bk = bk > 31 ? 31 : bk; }
        lut[n] = (unsigned char)bk; }
    __syncthreads();
}
__device__ __forceinline__ void attn_phase(const Frame& F, const bf16* __restrict__ Z, const bf16* __restrict__ CKV, const unsigned short* __restrict__ IDX, const float* __restrict__ t5, bf16* __restrict__ O, unsigned* __restrict__ wq) {
    LAS unsigned char* tile = F.lds + F.wave * AT_TILE;
    LAS unsigned short* idxl = (LAS unsigned short*)(tile + AT_IDX);
    LAS float* tb = (LAS float*)(F.lds + AT_TB); const LAS unsigned char* lut = F.lds + AT_LUT;
    LAS unsigned short* idxs = idxl + 256;
    const int lane = lane_id(), g = lane >> 4, i16 = lane & 15, q = i16 >> 2, p = i16 & 3, hd = i16 & 7, half = lane >> 5;
    const unsigned tbase = (unsigned)(size_t)tile;
    const int sh0 = (int)(xb_xcc_id() & 7u);
    for (int ss = 0; ss < 8; ++ss) {
      const int shard = (sh0 + ss) & 7;
      for (;;) {
        int item = 0; if (lane == 0) item = (int)__hip_atomic_fetch_add(wq + 64 * shard, 1u, RLX_AGENT);
        item = __builtin_amdgcn_readfirstlane(item);
        if (item >= M / 8) break;
        const int m = shard * (M / 8) + item;
        const int t = m & (SEQ - 1); const size_t brow = (size_t)(m - t);
        { const v2u iv = *(const GAS v2u*)(IDX + (size_t)m * TOPK + 4 * lane); *(LAS v2u*)(idxl + 4 * lane) = iv;
          v2u sv; sv.x = (((iv.x & 0xFFFFu) == 0xFFFFu) ? 0u : (iv.x & 0xFFFFu)) | (((iv.x >> 16) == 0xFFFFu) ? 0u : (iv.x & 0xFFFF0000u));
          sv.y = (((iv.y & 0xFFFFu) == 0xFFFFu) ? 0u : (iv.y & 0xFFFFu)) | (((iv.y >> 16) == 0xFFFFu) ? 0u : (iv.y & 0xFFFF0000u));
          *(LAS v2u*)(idxs + 4 * lane) = sv; }
        bf16x8 qf[8];
#pragma unroll
        for (int ks = 0; ks < 8; ++ks) { const bf16x8 v = *(const GAS bf16x8*)(Z + (size_t)m * NZ + hd * 256 + 32 * ks + 8 * g); qf[ks] = (i16 < 8) ? v : (bf16x8){0, 0, 0, 0, 0, 0, 0, 0}; }
        f32x4 oacc[16];
#pragma unroll
        for (int c = 0; c < 16; ++c) oacc[c] = (f32x4){0.f, 0.f, 0.f, 0.f};
        float mrun = -INFINITY, lrun = 0.f;
        const bf16* gb = CKV + brow * 256 + (lane & 31) * 8;
        LDS_WAIT();
#define AT_GATHER(chv) { const v4u i0_ = *(const LAS v4u*)(idxs + (chv) * 32 + 16 * half), i1_ = *(const LAS v4u*)(idxs + (chv) * 32 + 16 * half + 8); \
            const unsigned iw_[8] = {i0_.x, i0_.y, i0_.z, i0_.w, i1_.x, i1_.y, i1_.z, i1_.w}; \
            _Pragma("unroll") for (int j = 0; j < 16; ++j) { const unsigned kid_ = (j & 1) ? (iw_[j >> 1] >> 16) : (iw_[j >> 1] & 0xFFFFu); \
                __builtin_amdgcn_global_load_lds((const unsigned*)(gb + ((size_t)kid_ << 8)), (LAS unsigned*)(tile + j * AT_BP), 16, 0, 0); } }
        AT_GATHER(0)
        for (int ch = 0; ch < 8; ++ch) {
            asm volatile("s_waitcnt vmcnt(0)" ::: "memory");
            f32x4 lg[2];
#pragma unroll
            for (int mt = 0; mt < 2; ++mt) { f32x4 a_ = {0.f, 0.f, 0.f, 0.f};
#pragma unroll
                for (int ks = 0; ks < 8; ++ks) { const bf16x8 cf = *(const LAS bf16x8*)(tile + i16 * AT_BP + 512 * mt + 64 * ks + 16 * g); a_ = __builtin_amdgcn_mfma_f32_16x16x32_bf16(cf, qf[ks], a_, 0, 0, 0); }
                lg[mt] = a_; }
            bf16x8 pv[16];
            const unsigned trb = tbase + (unsigned)((4 * g + q) * AT_BP + 8 * p);
#define AT_TR4(c0) { bf16x4 l0, h0, l1, h1, l2, h2, l3, h3; \
                asm volatile("ds_read_b64_tr_b16 %0, %8 offset:%9\n\tds_read_b64_tr_b16 %1, %8 offset:%10\n\tds_read_b64_tr_b16 %2, %8 offset:%11\n\tds_read_b64_tr_b16 %3, %8 offset:%12\n\t" \
                             "ds_read_b64_tr_b16 %4, %8 offset:%13\n\tds_read_b64_tr_b16 %5, %8 offset:%14\n\tds_read_b64_tr_b16 %6, %8 offset:%15\n\tds_read_b64_tr_b16 %7, %8 offset:%16\n\ts_waitcnt lgkmcnt(0)" \
                             : "=&v"(l0), "=&v"(h0), "=&v"(l1), "=&v"(h1), "=&v"(l2), "=&v"(h2), "=&v"(l3), "=&v"(h3) \
                             : "v"(trb), "n"(32 * (c0)), "n"(512 + 32 * (c0)), "n"(32 * ((c0) + 1)), "n"(512 + 32 * ((c0) + 1)), "n"(32 * ((c0) + 2)), "n"(512 + 32 * ((c0) + 2)), "n"(32 * ((c0) + 3)), "n"(512 + 32 * ((c0) + 3)) : "memory"); \
                pv[(c0)] = __builtin_shufflevector(l0, h0, 0, 1, 2, 3, 4, 5, 6, 7); pv[(c0) + 1] = __builtin_shufflevector(l1, h1, 0, 1, 2, 3, 4, 5, 6, 7); \
                pv[(c0) + 2] = __builtin_shufflevector(l2, h2, 0, 1, 2, 3, 4, 5, 6, 7); pv[(c0) + 3] = __builtin_shufflevector(l3, h3, 0, 1, 2, 3, 4, 5, 6, 7); }
            AT_TR4(0) AT_TR4(4) AT_TR4(8) AT_TR4(12)
#undef AT_TR4
            if (ch < 7) AT_GATHER(ch + 1)
            float pr[2][4]; float cm = -INFINITY;
#pragma unroll
            for (int mt = 0; mt < 2; ++mt) { const v2u iw = *(const LAS v2u*)(idxl + ch * 32 + 16 * mt + 4 * g);
#pragma unroll
                for (int r = 0; r < 4; ++r) { const unsigned kv = ((r & 2) ? iw.y : iw.x) >> ((r & 1) * 16) & 0xFFFFu;
                    const unsigned dist = (unsigned)(t - (int)kv);
                    const unsigned bk = lut[dist < 128u ? dist : 128u];
                    float x = lg[mt][r] + tb[bk * 8 + hd];
                    x = (kv == 0xFFFFu) ? -INFINITY : x;
                    pr[mt][r] = x; cm = fmaxf(cm, x); } }
            cm = fmaxf(cm, __shfl_xor(cm, 16)); cm = fmaxf(cm, __shfl_xor(cm, 32));
            const float mnew = fmaxf(mrun, cm);
            const float alpha = __expf(mrun - mnew);
            float ls = 0.f;
#pragma unroll
            for (int mt = 0; mt < 2; ++mt)
#pragma unroll
                for (int r = 0; r < 4; ++r) { const float e = __expf(pr[mt][r] - mnew); pr[mt][r] = e; ls += e; }
            ls += __shfl_xor(ls, 16); ls += __shfl_xor(ls, 32);
            lrun = lrun * alpha + ls; mrun = mnew;
            v4u pw; pw.x = pk2(pr[0][0], pr[0][1]); pw.y = pk2(pr[0][2], pr[0][3]); pw.z = pk2(pr[1][0], pr[1][1]); pw.w = pk2(pr[1][2], pr[1][3]);
            const bf16x8 pf = __builtin_bit_cast(bf16x8, pw);
            if (__builtin_amdgcn_readfirstlane(__ballot(alpha != 1.0f) != 0ull)) {
#pragma unroll
                for (int c = 0; c < 16; ++c) oacc[c] = oacc[c] * alpha; }
#pragma unroll
            for (int c = 0; c < 16; ++c) oacc[c] = __builtin_amdgcn_mfma_f32_16x16x32_bf16(pv[c], pf, oacc[c], 0, 0, 0);
        }
#undef AT_GATHER
        const float inv = 1.0f / lrun;
        if (i16 < 8) {
            bf16* op = O + (size_t)m * KO + hd * 256 + 4 * g;
#pragma unroll
            for (int c = 0; c < 16; ++c) { v2u o; o.x = pk2(oacc[c][0] * inv, oacc[c][1] * inv); o.y = pk2(oacc[c][2] * inv, oacc[c][3] * inv); *(GAS v2u*)(op + 16 * c) = o; }
        }
      }
    }
}

constexpr int CP = 144;
constexpr int CSLOT = 64 * CP;
constexpr int S_A = 0, S_B = 1, S_K = 2, S_R = 3, S_V = 4, S_LAK = 5, S_MBR = 6, S_MKR = 7, S_T = 8, S_TH = 9, S_PH = 10, S_L = 11, S_TB = 12, S_LA = 13, S_LB = 14, S_G2 = S_B, S_OM = S_MBR;
constexpr int C_GC = 15 * CSLOT;
static_assert(C_GC + 256 + 2048 <= SCR_BYTES, "chunk phase LDS");
__device__ __forceinline__ bf16x8 rowfrag(LAS unsigned char* slot, int tile, int ks, int ln, int hl) { return *(const LAS bf16x8*)(slot + (32 * tile + ln) * CP + 32 * ks + 16 * hl); }
__device__ __forceinline__ void trfrag4(unsigned a, bf16x8 (&f)[4]) {
    bf16x4 l0, h0, l1, h1, l2, h2, l3, h3;
    asm volatile("ds_read_b64_tr_b16 %0, %8 offset:%9\n\tds_read_b64_tr_b16 %1, %8 offset:%10\n\tds_read_b64_tr_b16 %2, %8 offset:%11\n\tds_read_b64_tr_b16 %3, %8 offset:%12\n\t"
                 "ds_read_b64_tr_b16 %4, %8 offset:%13\n\tds_read_b64_tr_b16 %5, %8 offset:%14\n\tds_read_b64_tr_b16 %6, %8 offset:%15\n\tds_read_b64_tr_b16 %7, %8 offset:%16\n\ts_waitcnt lgkmcnt(0)"
                 : "=&v"(l0), "=&v"(h0), "=&v"(l1), "=&v"(h1), "=&v"(l2), "=&v"(h2), "=&v"(l3), "=&v"(h3)
                 : "v"(a), "n"(0), "n"(4 * CP), "n"(16 * CP), "n"(20 * CP), "n"(32 * CP), "n"(36 * CP), "n"(48 * CP), "n"(52 * CP) : "memory");
    f[0] = __builtin_shufflevector(l0, h0, 0, 1, 2, 3, 4, 5, 6, 7); f[1] = __builtin_shufflevector(l1, h1, 0, 1, 2, 3, 4, 5, 6, 7);
    f[2] = __builtin_shufflevector(l2, h2, 0, 1, 2, 3, 4, 5, 6, 7); f[3] = __builtin_shufflevector(l3, h3, 0, 1, 2, 3, 4, 5, 6, 7);
}
__device__ __forceinline__ unsigned trbase(LAS unsigned char* slot, int tile, int lane) { const int hl = lane >> 5, blk = (lane >> 4) & 1, q = (lane & 15) >> 2, p = lane & 3;
    return (unsigned)(size_t)slot + (unsigned)((8 * hl + q) * CP + 64 * tile + 32 * blk + 8 * p); }
template <int AM, int BM> __device__ __forceinline__ f32x16 mm_tile(LAS unsigned char* sa, int ta, LAS unsigned char* sb, int tb, f32x16 acc, int lane) {
    const int ln = lane & 31, hl = lane >> 5;
    const unsigned tra = trbase(sa, ta, lane), trb = trbase(sb, tb, lane);
    bf16x8 a[4], b[4];
    if constexpr (AM == 0) {
#pragma unroll
        for (int ks = 0; ks < 4; ++ks) a[ks] = rowfrag(sa, ta, ks, ln, hl);
    } else trfrag4(tra, a);
    if constexpr (BM == 0) {
#pragma unroll
        for (int ks = 0; ks < 4; ++ks) b[ks] = rowfrag(sb, tb, ks, ln, hl);
    } else trfrag4(trb, b);
#pragma unroll
    for (int ks = 0; ks < 4; ++ks) acc = __builtin_amdgcn_mfma_f32_32x32x16_bf16(a[ks], b[ks], acc, 0, 0, 0);
    return acc;
}
__device__ __forceinline__ int crow32(int reg, int hl) { return (reg & 3) + 8 * (reg >> 2) + 4 * hl; }
__device__ __forceinline__ void tile_store_T(LAS unsigned char* slot, int rt, int ct, const f32x16& v, int lane) {
    const int ln = lane & 31, hl = lane >> 5;
#pragma unroll
    for (int q4 = 0; q4 < 4; ++q4) { v2u o; o.x = pk2(v[4 * q4], v[4 * q4 + 1]); o.y = pk2(v[4 * q4 + 2], v[4 * q4 + 3]);
        *(LAS v2u*)(slot + (32 * ct + ln) * CP + (32 * rt + 8 * q4 + 4 * hl) * 2) = o; }
}
__device__ __forceinline__ f32x16 tile_load_T(LAS unsigned char* slot, int rt, int ct, int lane) {
    const int ln = lane & 31, hl = lane >> 5; f32x16 v;
#pragma unroll
    for (int q4 = 0; q4 < 4; ++q4) { const v2u o = *(const LAS v2u*)(slot + (32 * ct + ln) * CP + (32 * rt + 8 * q4 + 4 * hl) * 2);
        v[4 * q4] = bflo(o.x); v[4 * q4 + 1] = bfhi(o.x); v[4 * q4 + 2] = bflo(o.y); v[4 * q4 + 3] = bfhi(o.y); }
    return v;
}
__device__ __forceinline__ f32x16 zero16() { f32x16 v;
#pragma unroll
    for (int r = 0; r < 16; ++r) v[r] = 0.f;
    return v; }

template <int REPC>
__device__ __forceinline__ void chunk_phase(const Frame& F, const bf16* __restrict__ Z, const bf16* __restrict__ LAp, const bf16* __restrict__ WLp, const float* __restrict__ w0v, const float* __restrict__ a0v, const float* __restrict__ mu, const float* __restrict__ k_k, const float* __restrict__ k_a, const float* __restrict__ r_k,
                                            bf16* __restrict__ RHO, bf16* __restrict__ ZL, bf16* __restrict__ PT, bf16* __restrict__ QT, float* __restrict__ BON) {
    const int lane = lane_id(), ln = lane & 31, hl = lane >> 5;
#define WL() int w = F.wave; asm volatile("" : "+s"(w))
    LAS unsigned char* L = F.lds;
#define SLOT(s) (L + (s) * CSLOT)
    LAS float* GC = (LAS float*)(L + C_GC);
    float zr[9], zk[9], zv[9]; bf16x8 lfa[6], lfb[6];
#define CH_LOAD(tk) { const int b_ = (tk) >> 10, h_ = ((tk) >> 6) & 15, c_ = (tk) & 63; int w_ = F.wave; asm volatile("" : "+s"(w_)); const int t0w_ = 8 * w_, hc_ = h_ * 64 + lane; \
        const int tok_ = b_ * SEQ + c_ * CH; const bf16* zrow_ = Z + (size_t)(tok_ + t0w_) * NZ + hc_; \
        _Pragma("unroll") for (int q = 0; q < 9; ++q) { const bool ok_ = (q > 0) || (c_ * CH + t0w_ > 0); const bf16* rp_ = zrow_ + (ptrdiff_t)(q - 1) * NZ; \
            zr[q] = 0.f; zk[q] = 0.f; zv[q] = 0.f; if (ok_) { zr[q] = bf2f(rp_[ZC_R]); zk[q] = bf2f(rp_[ZC_K]); zv[q] = bf2f(rp_[ZC_V]); } } \
        const int mm_ = w_ >> 2, rt_ = (w_ >> 1) & 1, ct_ = w_ & 1; \
        const bf16* ap_ = LAp + (size_t)mm_ * M * 256 + (size_t)(tok_ + 32 * rt_ + ln) * 256 + 8 * hl; const bf16* bp_ = WLp + (size_t)mm_ * 1024 * 256 + (size_t)(h_ * 64 + 32 * ct_ + ln) * 256 + 8 * hl; \
        _Pragma("unroll") for (int ks = 0; ks < 6; ++ks) { lfa[ks] = *(const GAS bf16x8*)(ap_ + 16 * ks); lfb[ks] = *(const GAS bf16x8*)(bp_ + 16 * ks); } }
    if (F.vcu < BATCH * 16 * NCH) CH_LOAD(F.vcu)
    for (int repc = 0; repc < REPC; ++repc)
    for (int task = F.vcu; task < BATCH * 16 * NCH; task += F.G) {
        const int b = task >> 10, h = (task >> 6) & 15, c = task & 63;
        const int tok0 = b * SEQ + c * CH;
        const size_t base = (size_t)tok0 * 1024 + h * 64;
        const size_t tbo = (size_t)task * 4096;
        LAS float* DL = (LAS float*)SLOT(8);
        {
            WL();
            const int mm = w >> 2, rt = (w >> 1) & 1, ct = w & 1; const int jc = 32 * ct + ln;
            f32x16 d = zero16();
#pragma unroll
            for (int ks = 0; ks < 6; ++ks) d = __builtin_amdgcn_mfma_f32_32x32x16_bf16(lfa[ks], lfb[ks], d, 0, 0, 0);
            const float bias = mm ? a0v[h * 64 + jc] : w0v[h * 64 + jc];
#pragma unroll
            for (int r = 0; r < 16; ++r) { const float x = d[r] + bias; float y;
                if (mm == 0) { const float nx = -x; const float sp = fmaxf(nx, 0.f) + 0.69314718056f * __builtin_amdgcn_logf(1.0f + __builtin_amdgcn_exp2f(-1.44269504089f * fabsf(nx)));
                    y = __builtin_amdgcn_exp2f(-1.44269504089f * __builtin_amdgcn_exp2f(-1.44269504089f * (sp + 0.5f))); }
                else y = __builtin_amdgcn_rcpf(1.0f + __builtin_amdgcn_exp2f(-1.44269504089f * x));
                DL[mm * 4096 + (32 * rt + crow32(r, hl)) * 64 + jc] = y; }
        }
        __syncthreads();
        {
            WL();
            const int t0w = 8 * w; const int hc = h * 64 + lane;
            const float mur = mu[hc], muk = mu[1024 + hc], muv = mu[2048 + hc], kkc = k_k[hc], kac = k_a[hc], rkc = r_k[hc];
            float wo[8], a8[8];
#pragma unroll
            for (int tt = 0; tt < 8; ++tt) { wo[tt] = DL[(t0w + tt) * 64 + lane]; a8[tt] = DL[4096 + (t0w + tt) * 64 + lane]; }
            float k8[8], b8[8], kk8[8], r8[8], v8[8]; float bonv = 0.f;
#pragma unroll
            for (int tt = 0; tt < 8; ++tt) {
                const float r = zr[tt + 1] + (zr[tt] - zr[tt + 1]) * mur, km = zk[tt + 1] + (zk[tt] - zk[tt + 1]) * muk, vv = zv[tt + 1] + (zv[tt] - zv[tt + 1]) * muv;
                const float kr = km * kkc; const float ss = wave_sum_f(kr * kr); const float kk = kr * (1.0f / fmaxf(sqrtf(ss), 1e-12f));
                const float a = a8[tt]; const float kp = km * (1.0f + (a - 1.0f) * kac);
                const float bon = wave_sum_f(r * kp * rkc); bonv = (lane == tt) ? bon : bonv;
                r8[tt] = r; v8[tt] = vv; k8[tt] = kp; kk8[tt] = kk; b8[tt] = kk * a; }
            if (lane < 8) BON[(size_t)task * 64 + t0w + lane] = bonv;
            float pw = wo[0];
#pragma unroll
            for (int tt = 1; tt < 8; ++tt) pw *= wo[tt];
            LAS float* PW = (LAS float*)(L + C_GC + 256);
            PW[w * 64 + lane] = pw;
            __syncthreads();
            float g = 1.0f;
#pragma unroll
            for (int ww = 0; ww < 7; ++ww) { const float pv = PW[ww * 64 + lane]; g = (ww < w) ? g * pv : g; }
            float xa[8], xb[8], xk[8], xr[8];
#pragma unroll
            for (int tt = 0; tt < 8; ++tt) { const float gp = g; g *= wo[tt]; const float ig = __builtin_amdgcn_rcpf(g);
                xa[tt] = -gp * kk8[tt]; xb[tt] = b8[tt] * ig; xk[tt] = k8[tt] * ig; xr[tt] = r8[tt] * g; }
            *(LAS v4u*)(SLOT(S_A) + lane * CP + 16 * w) = pack8(xa); *(LAS v4u*)(SLOT(S_B) + lane * CP + 16 * w) = pack8(xb);
            *(LAS v4u*)(SLOT(S_K) + lane * CP + 16 * w) = pack8(xk); *(LAS v4u*)(SLOT(S_R) + lane * CP + 16 * w) = pack8(xr);
            *(LAS v4u*)(SLOT(S_V) + lane * CP + 16 * w) = pack8(v8);
            if (w == 7) GC[lane] = g;
            { const int nt_ = (task + F.G < BATCH * 16 * NCH) ? task + F.G : ((repc + 1 < REPC) ? F.vcu : -1); if (nt_ >= 0) CH_LOAD(nt_) }
        }
        __syncthreads();
#pragma unroll
        for (int jj = 0; jj < 2; ++jj) {
            WL();
            const int job = 2 * w + jj, mm = job >> 2, rt = (job >> 1) & 1, ct = job & 1;
            LAS unsigned char* sa = (mm & 1) ? SLOT(S_K) : SLOT(S_B); LAS unsigned char* sb = (mm & 2) ? SLOT(S_R) : SLOT(S_A);
            f32x16 d = mm_tile<1, 1>(sa, rt, sb, ct, zero16(), lane);
            const int tcol = 32 * ct + ln;
#pragma unroll
            for (int r = 0; r < 16; ++r) { const int u = 32 * rt + crow32(r, hl); const bool keep = (mm <= 1) ? (u < tcol) : (u <= tcol); d[r] = keep ? d[r] : 0.f; }
            tile_store_T((mm == 0) ? SLOT(S_L) : ((mm == 1) ? SLOT(S_LAK) : (mm == 2 ? SLOT(S_MBR) : SLOT(S_MKR))), rt, ct, d, lane);
        }
        __syncthreads();
        {
            WL();
            const int rt = (w >> 1) & 1, ct = w & 1; const bool tw = w < 4;
            f32x16 tm = zero16();
            if (tw) { tm = tile_load_T(SLOT(S_L), rt, ct, lane);
#pragma unroll
                for (int r = 0; r < 16; ++r) tm[r] += (32 * rt + crow32(r, hl) == 32 * ct + ln) ? 1.0f : 0.0f;
                tile_store_T(SLOT(S_T), rt, ct, tm, lane); }
            else { const f32x16 d = mm_tile<1, 0>(SLOT(S_L), rt, SLOT(S_L), ct, zero16(), lane); tile_store_T(SLOT(S_LA), rt, ct, d, lane); }
            __syncthreads();
#pragma unroll
            for (int st = 1; st <= 5; ++st) {
                LAS unsigned char* tin = (st & 1) ? SLOT(S_T) : SLOT(S_TB); LAS unsigned char* tout = (st & 1) ? SLOT(S_TB) : SLOT(S_T);
                LAS unsigned char* lin = (st & 1) ? SLOT(S_LA) : SLOT(S_LB); LAS unsigned char* lout = (st & 1) ? SLOT(S_LB) : SLOT(S_LA);
                if (tw) { tm = mm_tile<1, 0>(tin, rt, lin, ct, tm, lane); tile_store_T(tout, rt, ct, tm, lane); }
                else if (st < 5) { const f32x16 d = mm_tile<1, 0>(lin, rt, lin, ct, zero16(), lane); tile_store_T(lout, rt, ct, d, lane); }
                __syncthreads();
            }
        }
        {
            WL();
            const int mm = w >> 2, rt = (w >> 1) & 1, ct = w & 1;
            const f32x16 d = mm_tile<1, 0>(SLOT(S_TB), rt, mm ? SLOT(S_MBR) : SLOT(S_B), ct, zero16(), lane);
            tile_store_T(mm ? SLOT(S_PH) : SLOT(S_TH), rt, ct, d, lane);
        }
        __syncthreads();
#pragma unroll
        for (int jj = 0; jj < 2; ++jj) {
            WL();
            const int job = 2 * w + jj, mm = job >> 2, rt = (job >> 1) & 1, ct = job & 1;
            if (mm == 0) {
                f32x16 d = mm_tile<0, 0>(SLOT(S_A), rt, SLOT(S_TH), ct, zero16(), lane);
                const int jc = 32 * ct + ln; const float gc = GC[jc];
#pragma unroll
                for (int q4 = 0; q4 < 4; ++q4) { const int j0 = 32 * rt + 8 * q4 + 4 * hl; float x[4];
#pragma unroll
                    for (int e = 0; e < 4; ++e) x[e] = (d[4 * q4 + e] + ((j0 + e == jc) ? 1.0f : 0.0f)) * gc;
                    v2u o; o.x = pk2(x[0], x[1]); o.y = pk2(x[2], x[3]); *(GAS v2u*)(PT + tbo + (size_t)jc * 64 + j0) = o; }
            } else if (mm == 1) {
                const f32x16 d = mm_tile<1, 0>(SLOT(S_LAK), rt, SLOT(S_TH), ct, tile_load_T(SLOT(S_K), rt, ct, lane), lane);
                tile_store_T(SLOT(S_G2), rt, ct, d, lane);
            } else if (mm == 2) {
                const f32x16 d = mm_tile<0, 0>(SLOT(S_PH), rt, SLOT(S_A), ct, tile_load_T(SLOT(S_R), rt, ct, lane), lane);
#pragma unroll
                for (int r = 0; r < 16; ++r) RHO[(size_t)(tok0 + 32 * rt + crow32(r, hl)) * 1024 + h * 64 + 32 * ct + ln] = (bf16)f2bf(d[r]);
            } else {
                const f32x16 d = mm_tile<1, 0>(SLOT(S_LAK), rt, SLOT(S_PH), ct, tile_load_T(SLOT(S_MKR), rt, ct, lane), lane);
                tile_store_T(SLOT(S_OM), rt, ct, d, lane);
            }
        }
        __syncthreads();
        {
            WL();
            const int mm = w >> 2, rt = (w >> 1) & 1, ct = w & 1;
            const f32x16 d = mm_tile<0, 0>(SLOT(S_V), rt, mm ? SLOT(S_OM) : SLOT(S_G2), ct, zero16(), lane);
            if (mm == 0) { const int jc = 32 * ct + ln; const float gc = GC[jc];
#pragma unroll
                for (int r = 0; r < 16; ++r) QT[tbo + (size_t)(32 * rt + crow32(r, hl)) * 64 + jc] = (bf16)f2bf(d[r] * gc);
            } else {
#pragma unroll
                for (int r = 0; r < 16; ++r) ZL[tbo + (size_t)(32 * rt + crow32(r, hl)) * 64 + 32 * ct + ln] = (bf16)f2bf(d[r]);
            }
        }
        __syncthreads();
    }
#undef SLOT
#undef WL
#undef CH_LOAD
}

__device__ __forceinline__ void chain_phase(const Frame& F, const bf16* __restrict__ PT, const bf16* __restrict__ QT, bf16* __restrict__ SB) {
    if ((int)blockIdx.x < BATCH * 16 && F.wave == 0) {
        const int bh = blockIdx.x, lane = lane_id(), hl = lane >> 5, ln = lane & 31;
        f32x16 T[2][2];
#pragma unroll
        for (int a = 0; a < 2; ++a)
#pragma unroll
            for (int b = 0; b < 2; ++b) T[a][b] = zero16();
        v2u pa0[2][4][2], pa1[2][4][2], qa0[2][2][4], qa1[2][2][4];
#define CHN_LOAD(pa, qa, c_) { const size_t tb_ = ((size_t)bh * NCH + (c_)) * 4096; \
            _Pragma("unroll") for (int jt = 0; jt < 2; ++jt) _Pragma("unroll") for (int sp = 0; sp < 4; ++sp) { const bf16* ap = PT + tb_ + (size_t)(32 * jt + ln) * 64 + 16 * sp + 4 * hl; \
                pa[jt][sp][0] = *(const GAS v2u*)ap; pa[jt][sp][1] = *(const GAS v2u*)(ap + 8); } \
            _Pragma("unroll") for (int jt = 0; jt < 2; ++jt) _Pragma("unroll") for (int it = 0; it < 2; ++it) _Pragma("unroll") for (int q4 = 0; q4 < 4; ++q4) \
                qa[jt][it][q4] = *(const GAS v2u*)(QT + tb_ + (size_t)(32 * it + ln) * 64 + 32 * jt + 8 * q4 + 4 * hl); }
#define CHN_STEP(pa, qa, pan, qan, c_) { const size_t tb = ((size_t)bh * NCH + (c_)) * 4096; \
            if ((c_) + 1 < NCH) CHN_LOAD(pan, qan, (c_) + 1) \
            bf16x8 Bf[2][4]; \
            _Pragma("unroll") for (int it = 0; it < 2; ++it) _Pragma("unroll") for (int sp = 0; sp < 4; ++sp) { const f32x16& X = T[sp >> 1][it]; const int s_ = sp & 1; v4u pw; \
                pw.x = pk2(X[8 * s_ + 0], X[8 * s_ + 1]); pw.y = pk2(X[8 * s_ + 2], X[8 * s_ + 3]); pw.z = pk2(X[8 * s_ + 4], X[8 * s_ + 5]); pw.w = pk2(X[8 * s_ + 6], X[8 * s_ + 7]); \
                Bf[it][sp] = __builtin_bit_cast(bf16x8, pw); \
                  \
                bf16* sp_ = SB + tb + (size_t)(32 * it + ln) * 64 + 16 * sp + 4 * hl; \
                *(GAS v2u*)sp_ = (v2u){pw.x, pw.y}; *(GAS v2u*)(sp_ + 8) = (v2u){pw.z, pw.w}; } \
            f32x16 Tn[2][2]; \
            _Pragma("unroll") for (int jt = 0; jt < 2; ++jt) _Pragma("unroll") for (int it = 0; it < 2; ++it) _Pragma("unroll") for (int q4 = 0; q4 < 4; ++q4) { const v2u o = qa[jt][it][q4]; \
                Tn[jt][it][4 * q4] = bflo(o.x); Tn[jt][it][4 * q4 + 1] = bfhi(o.x); Tn[jt][it][4 * q4 + 2] = bflo(o.y); Tn[jt][it][4 * q4 + 3] = bfhi(o.y); } \
            _Pragma("unroll") for (int jt = 0; jt < 2; ++jt) _Pragma("unroll") for (int sp = 0; sp < 4; ++sp) { \
                const v4u aw = {pa[jt][sp][0].x, pa[jt][sp][0].y, pa[jt][sp][1].x, pa[jt][sp][1].y}; const bf16x8 Af = __builtin_bit_cast(bf16x8, aw); \
                _Pragma("unroll") for (int it = 0; it < 2; ++it) Tn[jt][it] = __builtin_amdgcn_mfma_f32_32x32x16_bf16(Af, Bf[it][sp], Tn[jt][it], 0, 0, 0); } \
            _Pragma("unroll") for (int jt = 0; jt < 2; ++jt) _Pragma("unroll") for (int it = 0; it < 2; ++it) T[jt][it] = Tn[jt][it]; }
        CHN_LOAD(pa0, qa0, 0)
#pragma unroll 1
        for (int c = 0; c < NCH; c += 2) { CHN_STEP(pa0, qa0, pa1, qa1, c) CHN_STEP(pa1, qa1, pa0, qa0, c + 1) }
#undef CHN_STEP
#undef CHN_LOAD
    }
}

constexpr int RO_TILE = 17408, RO_P = 65;
__device__ __forceinline__ void rwkv_out_phase(const Frame& F, const bf16* __restrict__ SB, const bf16* __restrict__ RHO, const bf16* __restrict__ ZL, const bf16* __restrict__ Z, const float* __restrict__ BON, const bf16* __restrict__ G,
                                               const float* __restrict__ mu, const float* __restrict__ ln_w, const float* __restrict__ ln_b, bf16* __restrict__ O) {
    const int gw = F.vcu * NWAVES + F.wave, NGW = F.G * NWAVES, lane = lane_id(), ln = lane & 31, hl = lane >> 5;
    LAS float* tile = (LAS float*)(F.lds + F.wave * RO_TILE); LAS float* bon = tile + 64 * RO_P;
    for (int task = gw; task < BATCH * 16 * NCH; task += NGW) {
        const int b = task >> 10, h = (task >> 6) & 15, c = task & 63;
        const size_t tbo = (size_t)task * 4096;
        const int tok0 = b * SEQ + c * CH;
        const size_t base = (size_t)tok0 * 1024 + h * 64;
        bon[lane] = BON[(size_t)task * 64 + lane];
        f32x16 acc[2][2];
#pragma unroll
        for (int rt = 0; rt < 2; ++rt)
#pragma unroll
            for (int ct = 0; ct < 2; ++ct)
#pragma unroll
                for (int r = 0; r < 16; ++r) acc[rt][ct][r] = bf2f(ZL[tbo + (size_t)(32 * rt + crow32(r, hl)) * 64 + 32 * ct + ln]);
#pragma unroll
        for (int ks = 0; ks < 4; ++ks) {
            bf16x8 af[2], bfr[2];
#pragma unroll
            for (int rt = 0; rt < 2; ++rt) af[rt] = *(const GAS bf16x8*)(SB + tbo + (size_t)(32 * rt + ln) * 64 + 16 * ks + 8 * hl);
#pragma unroll
            for (int ct = 0; ct < 2; ++ct) bfr[ct] = *(const GAS bf16x8*)(RHO + (size_t)(tok0 + 32 * ct + ln) * 1024 + h * 64 + 16 * ks + 8 * hl);
#pragma unroll
            for (int rt = 0; rt < 2; ++rt)
#pragma unroll
                for (int ct = 0; ct < 2; ++ct) acc[rt][ct] = __builtin_amdgcn_mfma_f32_32x32x16_bf16(af[rt], bfr[ct], acc[rt][ct], 0, 0, 0);
        }
#pragma unroll
        for (int ct = 0; ct < 2; ++ct) {
            float s1 = 0.f;
#pragma unroll
            for (int rt = 0; rt < 2; ++rt)
#pragma unroll
                for (int r = 0; r < 16; ++r) s1 += acc[rt][ct][r];
            s1 += __shfl_xor(s1, 32);
            const float mean = s1 * (1.0f / 64.0f); float s2 = 0.f;
#pragma unroll
            for (int rt = 0; rt < 2; ++rt)
#pragma unroll
                for (int r = 0; r < 16; ++r) { const float d = acc[rt][ct][r] - mean; s2 += d * d; }
            s2 += __shfl_xor(s2, 32);
            const float rstd = 1.0f / sqrtf(s2 * (1.0f / 64.0f) + GN_EPS);
#pragma unroll
            for (int rt = 0; rt < 2; ++rt)
#pragma unroll
                for (int r = 0; r < 16; ++r) tile[(32 * ct + ln) * RO_P + 32 * rt + crow32(r, hl)] = (acc[rt][ct][r] - mean) * rstd;
        }
        LDS_WAIT(); asm volatile("" ::: "memory");
        const float lw = ln_w[h * 64 + lane], lb = ln_b[h * 64 + lane], muv = mu[2048 + h * 64 + lane];
        const bf16* zvp = Z + (size_t)tok0 * NZ + ZC_V + h * 64 + lane;
        float zprev = (c > 0) ? bf2f(*(zvp - NZ)) : 0.f;
#pragma unroll 16
        for (int t = 0; t < CH; ++t) {
            const size_t o = base + (size_t)t * 1024 + lane;
            const float zcur = bf2f(zvp[(size_t)t * NZ]); const float vv = zcur + (zprev - zcur) * muv; zprev = zcur;
            const float yn = tile[t * RO_P + lane], bt = bon[t];
            const float val = (yn * lw + lb + bt * vv) * bf2f(G[o]);
            O[(size_t)(tok0 + t) * KO + 2048 + h * 64 + lane] = (bf16)f2bf(val);
        }
        LDS_WAIT(); asm volatile("" ::: "memory");
    }
}

#ifndef G_FOLD
#define G_FOLD 1
#endif
#ifndef G_FFI
#define G_FFI 1
#endif
#ifndef G_FFO
#define G_FFO 1
#endif
#ifndef G_WIN
#define G_WIN 1
#endif
#ifndef G_LORA
#define G_LORA 1
#endif
#ifndef G_WOUT
#define G_WOUT 1
#endif
#ifndef PH_TOPK
#define PH_TOPK 1
#endif
#ifndef PH_ATTN
#define PH_ATTN 1
#endif
#ifndef PH_SCAN
#define PH_SCAN 1
#endif
#ifndef PH_CHAIN
#define PH_CHAIN 1
#endif
#ifndef PH_ROUT
#define PH_ROUT 1
#endif
#ifndef PH_PREP
#define PH_PREP 1
#endif
#ifndef REPK
#define REPK -1
#endif
#ifndef MK_ONE_LAUNCH
#define MK_ONE_LAUNCH 1
#endif
#ifndef MK_LAST_PHASE
#define MK_LAST_PHASE 31
#endif
constexpr int NPHASE = 31;
#define mod ((float*)(ws + WS_MOD))
#define HN ((bf16*)(ws + WS_HN))
#define Hs ((bf16*)(ws + WS_DEC))
#define ACT ((bf16*)(ws + WS_ACT))
#define Z ((bf16*)(ws + WS_Z))
#define O ((bf16*)(ws + WS_O))
#define CKV ((bf16*)(ws + WS_CKV))
#define IDX ((unsigned short*)(ws + WS_IDX))
#define Rb ((bf16*)(ws + WS_R))
#define Vb ((bf16*)(ws + WS_V))
#define KKb ((bf16*)(ws + WS_KK))
#define Kb ((bf16*)(ws + WS_K))
#define BETAb ((bf16*)(ws + WS_BETA))
#define DECb ((float*)(ws + WS_DEC))
#define LA ((bf16*)(ws + WS_LA))
#define Gb ((bf16*)(ws + WS_G))
#define PT ((bf16*)(ws + WS_PT))
#define ST ((float*)(ws + WS_ST))
#define RHOb ((bf16*)(ws + WS_RHO))
#define SBb ((bf16*)(ws + WS_ST))
#define QT ((bf16*)(ws + WS_QT))
#define ZLOC ((bf16*)(ws + WS_ZLOC))
#define BONb ((float*)(ws + WS_K + 32 * MiB))
#define A1b ((bf16*)(ws + WS_BETA + 32 * MiB))
#define IN(k) (lo <= (k) && (k) < hi)
#define SEAM(k) do { if (IN(k) && IN((k) + 1)) { xcd_barrier(bar); if (REPK == 40) xcd_barrier(bar); } } while (0)
template <int l>
__device__ __forceinline__ void layer_phases(Frame& F, unsigned char* ws, float* out, const int lo, const int hi, const XcdBarrier& bar) {
        const int pb = 2 + 14 * l;
        const float* modl = mod + (size_t)l * BATCH * NMOD;
        const float* ng = KIN(I_NORMG) + (size_t)l * 3 * D;
        if (IN(pb + 0)) { if constexpr (l == 0) adaln_phase(F, KIN(I_X), ng, modl, 0, HN); else adaln_phase_h(F, Hs, ng, modl, 0, HN); }
        SEAM(pb + 0);
#if G_FFI
        if (IN(pb + 1)) { pg8::Gemm g{HN, (const bf16*)(ws + WS_WFI + (size_t)(2 * l) * WFI_ONE), M, NFI, D}; pg8::StaticOrder S; S.init(M, NFI, F.G, (int)blockIdx.x);
            pg8::EpiSwiglu E{ACT, FF}; pg8::gemm_phase<pg8::EpiSwiglu, pg8::StaticOrder, true, true>(F.lds, g, S, E, F.wave); if (REPK == 1) { __syncthreads(); pg8::gemm_phase<pg8::EpiSwiglu, pg8::StaticOrder, true, true>(F.lds, g, S, E, F.wave); } }
#endif
        SEAM(pb + 1);
#if G_FFO
        if (IN(pb + 2)) { pg8::Gemm g{ACT, (const bf16*)(ws + WS_WFO + (size_t)(2 * l) * WFO_ONE), M, D, FF}; pg8::StaticOrder S; S.init(M, D, F.G, (int)blockIdx.x, 2);
            pg8::EpiResidH<(l == 0)> E{l == 0 ? (const void*)KIN(I_X) : (const void*)Hs, Hs, D, modl + 2 * D, NMOD, RCOEF(0.5f)}; pg8::gemm_phase<pg8::EpiResidH<(l == 0)>, pg8::StaticOrder, true, true>(F.lds, g, S, E, F.wave); }
#endif
        SEAM(pb + 2);
        if (IN(pb + 3)) adaln_phase_h(F, Hs, ng + D, modl, 1, HN);
        SEAM(pb + 3);
#if G_WIN
        if (IN(pb + 4)) { pg8::Gemm g{HN, (const bf16*)(ws + WS_WIN + (size_t)l * WIN_ONE), M, NZ, D}; pg8::StaticOrder S; S.init(M, NZ, F.G, (int)blockIdx.x);
            pg8::EpiStoreBf16 E{Z, NZ}; pg8::gemm_phase<pg8::EpiStoreBf16, pg8::StaticOrder, true, true>(F.lds, g, S, E, F.wave); if (REPK == 4) { __syncthreads(); pg8::gemm_phase<pg8::EpiStoreBf16, pg8::StaticOrder, true, true>(F.lds, g, S, E, F.wave); } }
#endif
        SEAM(pb + 4);
        if (IN(pb + 5)) {
#if PH_PREP
            prep_phase(F, Z, KIN(I_MU) + (size_t)l * 3520, KIN(I_CKVG) + (size_t)l * 256, LA, CKV); if (REPK == 5) { __syncthreads(); prep_phase(F, Z, KIN(I_MU) + (size_t)l * 3520, KIN(I_CKVG) + (size_t)l * 256, LA, CKV); }
#endif
#if PH_TOPK
            topk_phase<((REPK == 61 || REPK == 63 || REPK == 64 || REPK == 65 || REPK == 66) ? 2 : 1), (REPK == 62 ? 2 : 1)>(F, Z, IDX);
            if (REPK == 6) { __syncthreads(); topk_phase<1, 1>(F, Z, IDX); }
#endif
        }
        SEAM(pb + 5);
        if (IN(pb + 6)) {
#if G_LORA
            { pg8::StaticOrder S; S.init(M, 1024, F.G, (int)blockIdx.x);
              pg8::Gemm g{LA + (size_t)2 * M * 256, (const bf16*)(ws + WS_WLORA + (size_t)(3 * l + 2) * WLORA_ONE), M, 1024, 256};
              pg8::EpiLora<2> E{nullptr, nullptr, nullptr, Gb, nullptr, nullptr, nullptr}; pg8::gemm_phase<pg8::EpiLora<2>, pg8::StaticOrder, true, true>(F.lds, g, S, E, F.wave); }
            __syncthreads();
#endif
#if PH_SCAN
            chunk_phase<(REPK == 81 ? 2 : 1)>(F, Z, LA, (const bf16*)(ws + WS_WLORA + (size_t)(3 * l) * WLORA_ONE), KIN(I_W0) + (size_t)l * 1024, KIN(I_A0) + (size_t)l * 1024, KIN(I_MU) + (size_t)l * 3520, KIN(I_KK) + (size_t)l * 1024, KIN(I_KA) + (size_t)l * 1024, KIN(I_RK) + (size_t)l * 1024, RHOb, ZLOC, PT, QT, BONb);
#endif
        }
        SEAM(pb + 6);
        if (IN(pb + 8)) {
            attn_setup(F, KIN(I_T5));
#if PH_CHAIN
            chain_phase(F, PT, QT, SBb);
#endif
#if PH_ATTN
            attn_phase(F, Z, CKV, IDX, KIN(I_T5), O, (unsigned*)(F.ctl + CW_WQ + 512 * l));
            if (REPK == 7) attn_phase(F, Z, CKV, IDX, KIN(I_T5), O, (unsigned*)(F.ctl + CW_WQ + 4096 + 512 * l));
#endif
        }
        SEAM(pb + 8);
#if PH_ROUT
        if (IN(pb + 9)) { rwkv_out_phase(F, SBb, RHOb, ZLOC, Z, BONb, Gb, KIN(I_MU) + (size_t)l * 3520, KIN(I_LNW) + (size_t)l * 1024, KIN(I_LNB) + (size_t)l * 1024, O); if (REPK == 10) { __syncthreads(); rwkv_out_phase(F, SBb, RHOb, ZLOC, Z, BONb, Gb, KIN(I_MU) + (size_t)l * 3520, KIN(I_LNW) + (size_t)l * 1024, KIN(I_LNB) + (size_t)l * 1024, O); } }
#endif
        SEAM(pb + 9);
#if G_WOUT
        if (IN(pb + 10)) { pg8::Gemm g{O, (const bf16*)(ws + WS_WOUT + (size_t)l * WOUT_ONE), M, D, KO}; pg8::StaticOrder S; S.init(M, D, F.G, (int)blockIdx.x, 2);
            pg8::EpiResidH<false> E{Hs, Hs, D, modl + (3 + 2) * D, NMOD, RCOEF(1.0f)}; pg8::gemm_phase<pg8::EpiResidH<false>, pg8::StaticOrder, true, true>(F.lds, g, S, E, F.wave); }
#endif
        SEAM(pb + 10);
        if (IN(pb + 11)) adaln_phase_h(F, Hs, ng + 2 * D, modl, 2, HN);
        SEAM(pb + 11);
#if G_FFI
        if (IN(pb + 12)) { pg8::Gemm g{HN, (const bf16*)(ws + WS_WFI + (size_t)(2 * l + 1) * WFI_ONE), M, NFI, D}; pg8::StaticOrder S; S.init(M, NFI, F.G, (int)blockIdx.x);
            pg8::EpiSwiglu E{ACT, FF}; pg8::gemm_phase<pg8::EpiSwiglu, pg8::StaticOrder, true, true>(F.lds, g, S, E, F.wave); if (REPK == 1) { __syncthreads(); pg8::gemm_phase<pg8::EpiSwiglu, pg8::StaticOrder, true, true>(F.lds, g, S, E, F.wave); } }
#endif
        SEAM(pb + 12);
#if G_FFO
        if (IN(pb + 13)) { pg8::Gemm g{ACT, (const bf16*)(ws + WS_WFO + (size_t)(2 * l + 1) * WFO_ONE), M, D, FF}; pg8::StaticOrder S; S.init(M, D, F.G, (int)blockIdx.x, 2);
            pg8::EpiResidH<false> E{Hs, Hs, D, modl + (6 + 2) * D, NMOD, RCOEF(0.5f)}; pg8::gemm_phase<pg8::EpiResidH<false>, pg8::StaticOrder, true, true>(F.lds, g, S, E, F.wave); }
#endif
        SEAM(pb + 13);
    }

__global__ void __launch_bounds__(NTHR, 2) hybrid_fwd(Params P) {
    extern __shared__ __attribute__((aligned(16))) unsigned char lds_raw[];
    Frame F;
    F.lds = (LAS unsigned char*)lds_raw;
    F.MISC = (volatile LAS unsigned*)(F.lds + MISC_OFF);
    F.wave = __builtin_amdgcn_readfirstlane((int)threadIdx.x >> 6);
    F.G = gridDim.x; { const int bx = blockIdx.x; F.vcu = (F.G % 8 == 0) ? (bx % 8) * (F.G / 8) + bx / 8 : bx; }
    unsigned char* ws = kargs()->ws;
    F.ws = ws; F.ctl = (gu32*)(ws + WS_CTL);
    for (int u = wtid(F.wave); u < (LDS_BYTES - LDSCTL_OFF) / 4; u += NTHR) ((LAS unsigned*)(F.lds + LDSCTL_OFF))[u] = 0u;
    __syncthreads();
    const int lo = kargs()->ph_lo, hi = kargs()->ph_hi;
    XcdBarrier bar; bar.bar = (unsigned*)(F.ctl + CW_BAR); bar.x = 0; bar.w0 = 0u; bar.st = nullptr;
    if (hi - lo > 1) bar = xcd_barrier_post((unsigned*)(F.ctl + CW_BAR), F.MISC + 8);
    bar.w0 = (F.wave == 0) ? 1u : 0u;
    float* const out = kargs()->out;

    if (IN(0)) { p0a_prologue(F); if (REPK == 20) { __syncthreads(); p0a_prologue(F); } } SEAM(0);
#if G_FOLD
    if (IN(1)) {
        for (int q = 0; q < 2 * DEPTH; ++q) {
            const int l = q >> 1, which = q & 1;
            const int c = (int)((blockIdx.x + F.G - 64 * q) % F.G);
            pg8::StaticOrder S; S.init(2048, 2048, F.G, c);
            const bf16* Ap = (const bf16*)(ws + (which ? WS_WOUTTA : WS_BDUK) + l * 4 * MiB); const bf16* Bp = (const bf16*)(ws + (which ? WS_BDUV : WS_WINQ) + l * 4 * MiB);
            bf16* Cp = which ? (bf16*)(ws + WS_WOUT + l * WOUT_ONE) : (bf16*)(ws + WS_WIN + l * WIN_ONE);
            pg8::Gemm g{Ap, Bp, 2048, 2048, 1024};
            pg8::EpiStoreBf16 E{Cp, which ? KO : D};
            pg8::gemm_phase<pg8::EpiStoreBf16, pg8::StaticOrder, true, true>(F.lds, g, S, E, F.wave);
            if (REPK == 21) { __syncthreads(); pg8::gemm_phase<pg8::EpiStoreBf16, pg8::StaticOrder, true, true>(F.lds, g, S, E, F.wave); }
        }
    }
#endif
    SEAM(1);
    layer_phases<0>(F, ws, out, lo, hi, bar);
    layer_phases<1>(F, ws, out, lo, hi, bar);
    if (IN(30)) final_norm_phase_h(F, Hs, out, KIN(I_FNG));
}

extern "C" void kernel_launch(void* const* d_in, const int* in_sizes, int n_in, void* d_out, int out_size, void* d_ws, size_t ws_size, hipStream_t stream) {
    static int grid = 0;
    if (grid == 0) {
        if (n_in != 25 || in_sizes[0] != M * D || out_size != M * D || ws_size < WS_END) { fprintf(stderr, "kernel_launch: unexpected problem (n_in %d, in0 %d, out %d, ws %zu < %zu)\n", n_in, n_in > 0 ? in_sizes[0] : -1, out_size, ws_size, (size_t)WS_END); grid = -1; return; }
        int dev = 0, cus = 0, per_cu = 0;
        if (hipGetDevice(&dev) != hipSuccess || hipDeviceGetAttribute(&cus, hipDeviceAttributeMultiprocessorCount, dev) != hipSuccess) { grid = -1; return; }
        if (hipFuncSetAttribute((const void*)hybrid_fwd, hipFuncAttributeMaxDynamicSharedMemorySize, LDS_BYTES) != hipSuccess) { fprintf(stderr, "kernel_launch: hipFuncSetAttribute failed\n"); grid = -1; return; }
        if (hipOccupancyMaxActiveBlocksPerMultiprocessor(&per_cu, (const void*)hybrid_fwd, NTHR, LDS_BYTES) != hipSuccess || per_cu < 1) { fprintf(stderr, "kernel_launch: occupancy query reports %d workgroups per CU\n", per_cu); }
        (void)hipGetLastError();
        grid = cus;
    }
    if (grid < 0) return;
    if (hipMemsetAsync((char*)d_ws + WS_CTL, 0, CTL_ZERO_BYTES, stream) != hipSuccess) return;
    Params p{};
    for (int i = 0; i < 25; ++i) p.in[i] = (const float*)d_in[i];
    p.out = (float*)d_out; p.ws = (unsigned char*)d_ws;
#if MK_ONE_LAUNCH
    p.ph_lo = 0; p.ph_hi = MK_LAST_PHASE;
    hipLaunchKernelGGL(hybrid_fwd, dim3(grid), dim3(NTHR), LDS_BYTES, stream, p);
#ifdef PROBE_LO
    if (hipMemsetAsync((char*)d_ws + WS_CTL, 0, CTL_ZERO_BYTES, stream) != hipSuccess) return;
    p.ph_lo = PROBE_LO; p.ph_hi = PROBE_HI; p.rerun = 1;
    hipLaunchKernelGGL(hybrid_fwd, dim3(grid), dim3(NTHR), LDS_BYTES, stream, p);
#endif
#else
    for (int ph = 0; ph < MK_LAST_PHASE; ++ph) { p.ph_lo = ph; p.ph_hi = ph + 1; hipLaunchKernelGGL(hybrid_fwd, dim3(grid), dim3(NTHR), LDS_BYTES, stream, p); }
#endif
}
```

```cpp
#include <hip/hip_runtime.h>
#include <cstdio>
#include <cstdint>

#ifndef REPK
#define REPK -1
#endif
constexpr int BATCH = 4, SEQ = 4096, D = 2048, DEPTH = 2, M = BATCH * SEQ;
constexpr int FF = 5632, NFI = 2 * FF;
constexpr int PIN = 5904;
constexpr int NZ = 7168;
constexpr int ZC_QLAT = 0, ZC_CKV = 2048, ZC_QIDX = 2304, ZC_KIDX = 3328, ZC_WIDX = 3392, ZC_WL = 3408, ZC_AL = 3504, ZC_GL = 3600, ZC_R = 4096, ZC_K = 5120, ZC_V = 6144;
constexpr int KO = 3072;
constexpr int TOPK = 256;
constexpr int NMOD = 9 * D;
constexpr float RMS_EPS = 1e-6f, GN_EPS = 64e-5f;
constexpr int CH = 64, NCH = SEQ / CH;

constexpr size_t MiB = 1u << 20;
constexpr size_t WS_CTL = 0, CTL_ZERO_BYTES = 1 * MiB;
constexpr size_t WS_MOD = 1 * MiB;
constexpr size_t WS_WFI = 2 * MiB, WFI_ONE = (size_t)NFI * D * 2;
constexpr size_t WS_WFO = 178 * MiB, WFO_ONE = (size_t)D * FF * 2;
constexpr size_t WS_WIN = 266 * MiB, WIN_ONE = (size_t)NZ * D * 2;
constexpr size_t WS_WOUT = 322 * MiB, WOUT_ONE = (size_t)D * KO * 2;
constexpr size_t WS_WLORA = 346 * MiB, WLORA_ONE = (size_t)1024 * 256 * 2;
constexpr size_t WS_HN = 350 * MiB;
constexpr size_t WS_ACT = 414 * MiB;
constexpr size_t WS_Z = 590 * MiB;
constexpr size_t WS_IDX = 814 * MiB;
constexpr size_t WS_CKV = 822 * MiB;
constexpr size_t WS_R = 830 * MiB, WS_V = 894 * MiB, WS_KK = 958 * MiB, WS_K = 1022 * MiB, WS_BETA = 1086 * MiB, WS_DEC = 1150 * MiB;
constexpr size_t WS_O = 1214 * MiB;
constexpr size_t WS_END = 1310 * MiB;
constexpr size_t WS_WINQ = WS_ACT, WS_WOUTTA = WS_ACT + 8 * MiB, WS_BDUK = WS_ACT + 16 * MiB, WS_BDUV = WS_ACT + 24 * MiB;
constexpr size_t WS_LA = WS_ACT;
constexpr size_t WS_G = WS_ACT + 24 * MiB;
constexpr size_t WS_PT = WS_ACT + 56 * MiB;
constexpr size_t WS_ST = WS_ACT + 88 * MiB;
constexpr size_t WS_RHO = WS_R + 32 * MiB, WS_QT = WS_V + 32 * MiB, WS_ZLOC = WS_KK + 32 * MiB;

constexpr int CW_BAR = 4096;
constexpr int CW_WQ = 16384;

constexpr int SCR_BYTES = 143360;
constexpr int LDSCTL_OFF = SCR_BYTES, MISC_OFF = LDSCTL_OFF + 320;
constexpr int LDS_BYTES = 147456;
constexpr int NWAVES = 8, NTHR = NWAVES * 64;

#define GAS __attribute__((address_space(1)))
#define LAS __attribute__((address_space(3)))
#define CAS __attribute__((address_space(4)))
typedef unsigned short bf16;
typedef unsigned v4u __attribute__((ext_vector_type(4)));
typedef unsigned v2u __attribute__((ext_vector_type(2)));
typedef float f32x4 __attribute__((ext_vector_type(4)));
typedef float f32x2 __attribute__((ext_vector_type(2)));
typedef float f32x16 __attribute__((ext_vector_type(16)));
typedef short bf16x8 __attribute__((ext_vector_type(8)));
typedef short bf16x4 __attribute__((ext_vector_type(4)));
typedef GAS unsigned gu32;
#define RLX_AGENT __ATOMIC_RELAXED, __HIP_MEMORY_SCOPE_AGENT
#define LDS_WAIT() asm volatile("s_waitcnt lgkmcnt(0)" ::: "memory")
#define VM_WAIT() asm volatile("s_waitcnt vmcnt(0)" ::: "memory")
__device__ __forceinline__ unsigned f2bf(float f) { unsigned u = __builtin_bit_cast(unsigned, f); return (u + 0x7fffu + ((u >> 16) & 1u)) >> 16; }
typedef __bf16 hwbf2 __attribute__((ext_vector_type(2)));
__device__ __forceinline__ unsigned pk2(float lo, float hi) { const f32x2 v = {lo, hi}; return __builtin_bit_cast(unsigned, __builtin_convertvector(v, hwbf2)); }
__device__ __forceinline__ float bflo(unsigned w) { return __builtin_bit_cast(float, w << 16); }
__device__ __forceinline__ float bfhi(unsigned w) { return __builtin_bit_cast(float, w & 0xffff0000u); }
__device__ __forceinline__ float bf2f(bf16 b) { return __builtin_bit_cast(float, ((unsigned)b) << 16); }
__device__ __forceinline__ float wave_sum(float v) {
#pragma unroll
    for (int o = 1; o < 64; o <<= 1) v += __shfl_xor(v, o);
    return v;
}
__device__ __forceinline__ float fast_exp(float x) { return __builtin_amdgcn_exp2f(x * 1.44269504089f); }
__device__ __forceinline__ float fast_sigmoid(float x) { return __builtin_amdgcn_rcpf(1.0f + fast_exp(-x)); }

__device__ __forceinline__ int ltid() { int t = threadIdx.x; asm volatile("" : "+v"(t)); return t; }
namespace pg8 {
#define PG8_LAS __attribute__((address_space(3)))
typedef unsigned short bf16_t;
typedef short bf16x8 __attribute__((ext_vector_type(8)));
typedef float f32x4 __attribute__((ext_vector_type(4)));
typedef unsigned u32x4 __attribute__((ext_vector_type(4)));
constexpr int BM = 256, BK = 64, HALF = 128, HTB = HALF * BK * 2  , STAGE_BYTES = 8 * HTB, NXCD = 8, WGM = 8;

__host__ __device__ __forceinline__ int lds_byte(int r, int c) { const int st = (r >> 4) * 2 + (c >> 5), rr = r & 15, cc = c & 31, ob = rr * 64 + cc * 2; return st * 1024 + (ob ^ (((ob >> 9) & 1) << 5)); }
__host__ __device__ __forceinline__ void stage_rc(int b, int& R, int& C) { const int st = b / 1024, sb = b % 1024, swz = sb ^ (((sb >> 9) & 1) << 5); R = (st >> 1) * 16 + swz / 64; C = (st & 1) * 32 + (swz % 64) / 2; }
__host__ __device__ __forceinline__ int perm32(int rho) { const int n = rho >> 4, i = rho & 15; return 8 * (i >> 2) + 4 * n + (i & 3); }

struct Unit { int pm, pn; };
struct Gemm { const bf16_t* A; const bf16_t* Bt; int M, N, K; };

struct StaticOrder {
    int nM, nN, nwg, G, c, wgm;
    __host__ __device__ void init(int M, int N, int G_, int c_, int wgm_ = WGM) { nM = M / BM; nN = N / BM; nwg = nM * nN; G = G_; c = c_; wgm = wgm_; }
    __host__ __device__ bool next(int i, Unit& u) const {
        const long L = (long)i * G + c; if (L >= nwg) return false;
        int wgid = (int)L; { const int q = nwg / NXCD, r = nwg % NXCD, xcd = wgid % NXCD, off = wgid / NXCD; wgid = (xcd < r ? xcd * (q + 1) : r * (q + 1) + (xcd - r) * q) + off; }
        const int nig = wgm * nN, gid = wgid / nig, fm = gid * wgm, gsz = (nM - fm) < wgm ? (nM - fm) : wgm;
        u.pm = fm + ((wgid % nig) % gsz); u.pn = (wgid % nig) / gsz; return true;
    }
    __device__ __forceinline__ void a_ready(const Unit&) const {}
    __device__ __forceinline__ size_t a_off(const Unit&) const { return 0; }
    __device__ __forceinline__ void done(const Unit&) const {}
};

__device__ __forceinline__ unsigned cvt_pk_bf16(float lo, float hi) { unsigned r; asm volatile("v_cvt_pk_bf16_f32 %0, %1, %2" : "=v"(r) : "v"(lo), "v"(hi)); return r; }
__device__ __forceinline__ unsigned cvt_pk_bf16_safe(float lo, float hi) { unsigned r; asm volatile("s_nop 1\n\tv_cvt_pk_bf16_f32 %0, %1, %2" : "=v"(r) : "v"(lo), "v"(hi)); return r; }
typedef float f32x2 __attribute__((ext_vector_type(2)));

struct EpiStoreBf16 {
    static constexpr bool PERM = true, AFTER_DRAIN = false;
    bf16_t* O; int ldc;
    __device__ __forceinline__ void operator()(const f32x4 (&acc)[2][2][4][2], const Unit& u, int wr, int wc, int fr, int fq) const {
        const int row0 = u.pm * BM + wr * 64 + fr, col0 = u.pn * BM + wc * 32 + 8 * fq;
#pragma unroll
        for (int ai = 0; ai < 2; ++ai)
#pragma unroll
            for (int m = 0; m < 4; ++m) { bf16_t* rowp = O + (size_t)(row0 + ai * HALF + m * 16) * ldc + col0;
#pragma unroll
                for (int bj = 0; bj < 2; ++bj) { const f32x4 v0 = acc[ai][bj][m][0], v1 = acc[ai][bj][m][1];
                    u32x4 w; w.x = cvt_pk_bf16(v0[0], v0[1]); w.y = cvt_pk_bf16(v0[2], v0[3]); w.z = cvt_pk_bf16(v1[0], v1[1]); w.w = cvt_pk_bf16(v1[2], v1[3]);
                    *(u32x4*)(rowp + bj * HALF) = w; } }
    }
};
struct EpiSwiglu {
    static constexpr bool PERM = true, AFTER_DRAIN = false;
    bf16_t* O; int ldc;
    __device__ __forceinline__ void operator()(const f32x4 (&acc)[2][2][4][2], const Unit& u, int wr, int wc, int fr, int fq) const {
        const int row0 = u.pm * BM + wr * 64 + fr, col0 = u.pn * HALF + wc * 32 + 8 * fq;
#pragma unroll
        for (int ai = 0; ai < 2; ++ai)
#pragma unroll
            for (int m = 0; m < 4; ++m) { bf16_t* rowp = O + (size_t)(row0 + ai * HALF + m * 16) * ldc + col0;
                f32x2 h[4];
#pragma unroll
                for (int n = 0; n < 2; ++n) { const f32x4 g = acc[ai][0][m][n], up = acc[ai][1][m][n];
#pragma unroll
                    for (int j = 0; j < 2; ++j) { const f32x2 g2 = {g[2 * j], g[2 * j + 1]}, u2 = {up[2 * j], up[2 * j + 1]};
                        const f32x2 t = g2 * -1.44269504089f; f32x2 d; d.x = __builtin_amdgcn_exp2f(t.x); d.y = __builtin_amdgcn_exp2f(t.y); d = d + 1.0f;
                        f32x2 r; r.x = __builtin_amdgcn_rcpf(d.x); r.y = __builtin_amdgcn_rcpf(d.y);
                        h[2 * n + j] = (g2 * u2) * r; } }
                u32x4 w; w.x = cvt_pk_bf16(h[0].x, h[0].y); w.y = cvt_pk_bf16(h[1].x, h[1].y); w.z = cvt_pk_bf16(h[2].x, h[2].y); w.w = cvt_pk_bf16(h[3].x, h[3].y);
                *(u32x4*)rowp = w; }
    }
};
struct EpiResid {
    static constexpr bool PERM = false, AFTER_DRAIN = false;
    const float* base; float* out; int ldc; const float* gate; int gate_bstride; float coef;
    __device__ __forceinline__ void operator()(const f32x4 (&acc)[2][2][4][2], const Unit& u, int wr, int wc, int fr, int fq) const {
        const int row0 = u.pm * BM + wr * 64 + fr, col0 = u.pn * BM + wc * 32 + 4 * fq;
        const float* gp = gate + (size_t)((u.pm * BM) >> 12) * gate_bstride + col0;
        f32x4 gv[2][2];
#pragma unroll
        for (int bj = 0; bj < 2; ++bj)
#pragma unroll
            for (int n = 0; n < 2; ++n) gv[bj][n] = *(const f32x4*)(gp + bj * HALF + n * 16) * coef;
        const float* bp = base + (size_t)row0 * ldc + col0; float* op = out + (size_t)row0 * ldc + col0;
        f32x4 b0[4][2][2], b1[4][2][2];
#pragma unroll
        for (int m = 0; m < 4; ++m)
#pragma unroll
            for (int bj = 0; bj < 2; ++bj)
#pragma unroll
                for (int n = 0; n < 2; ++n) b0[m][bj][n] = *(const f32x4*)(bp + (size_t)(m * 16) * ldc + bj * HALF + n * 16);
#pragma unroll
        for (int m = 0; m < 4; ++m)
#pragma unroll
            for (int bj = 0; bj < 2; ++bj)
#pragma unroll
                for (int n = 0; n < 2; ++n) b0[m][bj][n] += gv[bj][n] * acc[0][bj][m][n];
#pragma unroll
        for (int m = 0; m < 4; ++m)
#pragma unroll
            for (int bj = 0; bj < 2; ++bj)
#pragma unroll
                for (int n = 0; n < 2; ++n) b1[m][bj][n] = *(const f32x4*)(bp + (size_t)(HALF + m * 16) * ldc + bj * HALF + n * 16);
#pragma unroll
        for (int m = 0; m < 4; ++m)
#pragma unroll
            for (int bj = 0; bj < 2; ++bj)
#pragma unroll
                for (int n = 0; n < 2; ++n) *(f32x4*)(op + (size_t)(m * 16) * ldc + bj * HALF + n * 16) = b0[m][bj][n];
#pragma unroll
        for (int m = 0; m < 4; ++m)
#pragma unroll
            for (int bj = 0; bj < 2; ++bj)
#pragma unroll
                for (int n = 0; n < 2; ++n) *(f32x4*)(op + (size_t)(HALF + m * 16) * ldc + bj * HALF + n * 16) = b1[m][bj][n] + gv[bj][n] * acc[1][bj][m][n];
    }
};
template <bool BASE32> struct EpiResidH {
    static constexpr bool PERM = true, AFTER_DRAIN = false;
    const void* base; bf16_t* out; int ldc; const float* gate; int gate_bstride; float coef;
    __device__ __forceinline__ void operator()(const f32x4 (&acc)[2][2][4][2], const Unit& u, int wr, int wc, int fr, int fq) const {
        const int row0 = u.pm * BM + wr * 64 + fr, col0 = u.pn * BM + wc * 32 + 8 * fq;
        const float* gp = gate + (size_t)((u.pm * BM) >> 12) * gate_bstride + col0;
        f32x4 gv[2][2];
#pragma unroll
        for (int bj = 0; bj < 2; ++bj)
#pragma unroll
            for (int n = 0; n < 2; ++n) gv[bj][n] = *(const f32x4*)(gp + bj * HALF + 4 * n) * coef;
        bf16_t* op = out + (size_t)row0 * ldc + col0;
        if constexpr (!BASE32) {
            const bf16_t* bp = (const bf16_t*)base + (size_t)row0 * ldc + col0;
            u32x4 bb[2][4][2];
#pragma unroll
            for (int ai = 0; ai < 2; ++ai)
#pragma unroll
                for (int m = 0; m < 4; ++m)
#pragma unroll
                    for (int bj = 0; bj < 2; ++bj) bb[ai][m][bj] = *(const u32x4*)(bp + (size_t)(ai * HALF + m * 16) * ldc + bj * HALF);
#pragma unroll
            for (int ai = 0; ai < 2; ++ai)
#pragma unroll
                for (int m = 0; m < 4; ++m)
#pragma unroll
                    for (int bj = 0; bj < 2; ++bj) { const u32x4 b = bb[ai][m][bj]; const f32x4 a0 = acc[ai][bj][m][0] * gv[bj][0], a1 = acc[ai][bj][m][1] * gv[bj][1];
                        u32x4 w; w.x = cvt_pk_bf16(bflo(b.x) + a0[0], bfhi(b.x) + a0[1]); w.y = cvt_pk_bf16(bflo(b.y) + a0[2], bfhi(b.y) + a0[3]);
                        w.z = cvt_pk_bf16(bflo(b.z) + a1[0], bfhi(b.z) + a1[1]); w.w = cvt_pk_bf16(bflo(b.w) + a1[2], bfhi(b.w) + a1[3]);
                        *(u32x4*)(op + (size_t)(ai * HALF + m * 16) * ldc + bj * HALF) = w; }
        } else {
            const float* bp = (const float*)base + (size_t)row0 * ldc + col0;
#pragma unroll
            for (int ai = 0; ai < 2; ++ai) {
                f32x4 bf[4][2][2];
#pragma unroll
                for (int m = 0; m < 4; ++m)
#pragma unroll
                    for (int bj = 0; bj < 2; ++bj)
#pragma unroll
                        for (int n = 0; n < 2; ++n) bf[m][bj][n] = *(const f32x4*)(bp + (size_t)(ai * HALF + m * 16) * ldc + bj * HALF + 4 * n);
#pragma unroll
                for (int m = 0; m < 4; ++m)
#pragma unroll
                    for (int bj = 0; bj < 2; ++bj) { const f32x4 a0 = bf[m][bj][0] + acc[ai][bj][m][0] * gv[bj][0], a1 = bf[m][bj][1] + acc[ai][bj][m][1] * gv[bj][1];
                        u32x4 w; w.x = cvt_pk_bf16(a0[0], a0[1]); w.y = cvt_pk_bf16(a0[2], a0[3]); w.z = cvt_pk_bf16(a1[0], a1[1]); w.w = cvt_pk_bf16(a1[2], a1[3]);
                        *(u32x4*)(op + (size_t)(ai * HALF + m * 16) * ldc + bj * HALF) = w; }
            }
        }
    }
};
template <int MODE> struct EpiLora {
    static constexpr bool PERM = (MODE == 2), AFTER_DRAIN = false;
    float* o0; bf16_t* o0h; bf16_t* o1h; bf16_t* o2; const bf16_t* auxh; const float* v0; const float* v1;
    __device__ __forceinline__ void operator()(const f32x4 (&acc)[2][2][4][2], const Unit& u, int wr, int wc, int fr, int fq) const {
        const int row0 = u.pm * BM + wr * 64 + fr;
        if constexpr (MODE == 2) {
            const int col0 = u.pn * BM + wc * 32 + 8 * fq;
#pragma unroll
            for (int ai = 0; ai < 2; ++ai)
#pragma unroll
                for (int m = 0; m < 4; ++m) { bf16_t* rowp = o2 + (size_t)(row0 + ai * HALF + m * 16) * 1024 + col0;
#pragma unroll
                    for (int bj = 0; bj < 2; ++bj) { const f32x4 a0 = acc[ai][bj][m][0], a1 = acc[ai][bj][m][1];
                        u32x4 w; w.x = cvt_pk_bf16(a0[0], a0[1]); w.y = cvt_pk_bf16(a0[2], a0[3]); w.z = cvt_pk_bf16(a1[0], a1[1]); w.w = cvt_pk_bf16(a1[2], a1[3]);
                        *(u32x4*)(rowp + bj * HALF) = w; } }
        } else {
            const int col0 = u.pn * BM + wc * 32 + 4 * fq;
#pragma unroll
            for (int bj = 0; bj < 2; ++bj)
#pragma unroll
                for (int n = 0; n < 2; ++n) {
                    const int cc = col0 + bj * HALF + n * 16;
                    const f32x4 c0 = *(const f32x4*)(v0 + cc);
#pragma unroll
                    for (int ai = 0; ai < 2; ++ai)
#pragma unroll
                        for (int m = 0; m < 4; ++m) { const size_t o = (size_t)(row0 + ai * HALF + m * 16) * 1024 + cc; const f32x4 x = acc[ai][bj][m][n] + c0;
                            if constexpr (MODE == 0) { f32x4 r;
#pragma unroll
                                for (int j = 0; j < 4; ++j) { const float nx = -x[j];
                                    const float sp = fmaxf(nx, 0.f) + 0.69314718056f * __builtin_amdgcn_logf(1.0f + __builtin_amdgcn_exp2f(-1.44269504089f * fabsf(nx)));
                                    r[j] = __builtin_amdgcn_exp2f(-1.44269504089f * __builtin_amdgcn_exp2f(-1.44269504089f * (sp + 0.5f))); }
                                *(f32x4*)(o0 + o) = r; }
                            else { typedef unsigned u32x2 __attribute__((ext_vector_type(2))); float a[4];
#pragma unroll
                                for (int j = 0; j < 4; ++j) a[j] = __builtin_amdgcn_rcpf(1.0f + __builtin_amdgcn_exp2f(-1.44269504089f * x[j]));
                                u32x2 ao; ao.x = cvt_pk_bf16_safe(a[0], a[1]); ao.y = cvt_pk_bf16_safe(a[2], a[3]); *(u32x2*)(o1h + o) = ao; }
                            asm volatile("" ::: "memory"); }
                }
        }
    }
};

struct LoraOrder : StaticOrder {
    size_t a_stride;
    __device__ __forceinline__ size_t a_off(const Unit& u) const { return (size_t)(u.pn >> 2) * a_stride; }
};
struct EpiLoraAll {
    static constexpr bool PERM = false, AFTER_DRAIN = false;
    float* dec; bf16_t* kh; bf16_t* betah; bf16_t* gh; const bf16_t* kkh; const float* w0; const float* a0; const float* ka;
    __device__ __forceinline__ void operator()(const f32x4 (&acc)[2][2][4][2], const Unit& u, int wr, int wc, int fr, int fq) const {
        typedef unsigned u32x2 __attribute__((ext_vector_type(2)));
        const int mode = u.pn >> 2, row0 = u.pm * BM + wr * 64 + fr, col0 = (u.pn & 3) * BM + wc * 32 + 4 * fq;
#pragma unroll
        for (int bj = 0; bj < 2; ++bj)
#pragma unroll
            for (int n = 0; n < 2; ++n) {
                const int cc = col0 + bj * HALF + n * 16;
                f32x4 c0 = {0.f, 0.f, 0.f, 0.f}, c1 = {0.f, 0.f, 0.f, 0.f};
                if (mode == 0) c0 = *(const f32x4*)(w0 + cc); else if (mode == 1) { c0 = *(const f32x4*)(a0 + cc); c1 = *(const f32x4*)(ka + cc); }
#pragma unroll
                for (int ai = 0; ai < 2; ++ai)
#pragma unroll
                    for (int m = 0; m < 4; ++m) { const size_t o = (size_t)(row0 + ai * HALF + m * 16) * 1024 + cc; const f32x4 x = acc[ai][bj][m][n] + c0;
                        if (mode == 0) { f32x4 r;
#pragma unroll
                            for (int j = 0; j < 4; ++j) { const float nx = -x[j];
                                const float sp = fmaxf(nx, 0.f) + 0.69314718056f * __builtin_amdgcn_logf(1.0f + __builtin_amdgcn_exp2f(-1.44269504089f * fabsf(nx)));
                                r[j] = __builtin_amdgcn_exp2f(-1.44269504089f * __builtin_amdgcn_exp2f(-1.44269504089f * (sp + 0.5f))); }
                            *(f32x4*)(dec + o) = r; }
                        else if (mode == 1) {
                            const u32x2 kw = *(const u32x2*)(kh + o), kkw = *(const u32x2*)(kkh + o);
                            const float kv[4] = {__builtin_bit_cast(float, kw.x << 16), __builtin_bit_cast(float, kw.x & 0xffff0000u), __builtin_bit_cast(float, kw.y << 16), __builtin_bit_cast(float, kw.y & 0xffff0000u)};
                            const float kkv[4] = {__builtin_bit_cast(float, kkw.x << 16), __builtin_bit_cast(float, kkw.x & 0xffff0000u), __builtin_bit_cast(float, kkw.y << 16), __builtin_bit_cast(float, kkw.y & 0xffff0000u)};
                            float kn[4], bt[4];
#pragma unroll
                            for (int j = 0; j < 4; ++j) { const float a = __builtin_amdgcn_rcpf(1.0f + __builtin_amdgcn_exp2f(-1.44269504089f * x[j])); kn[j] = kv[j] * (1.0f + (a - 1.0f) * c1[j]); bt[j] = kkv[j] * a; }
                            u32x2 ko, bo; ko.x = cvt_pk_bf16(kn[0], kn[1]); ko.y = cvt_pk_bf16(kn[2], kn[3]); bo.x = cvt_pk_bf16(bt[0], bt[1]); bo.y = cvt_pk_bf16(bt[2], bt[3]);
                            *(u32x2*)(kh + o) = ko; *(u32x2*)(betah + o) = bo; }
                        else { u32x2 go; go.x = cvt_pk_bf16(x[0], x[1]); go.y = cvt_pk_bf16(x[2], x[3]); *(u32x2*)(gh + o) = go; }
                        asm volatile("" ::: "memory"); }
            }
    }
};
template <class Epi, class Sched, bool ALIGN_EPI = false, bool SP2 = false>
__device__ __forceinline__ void gemm_phase(PG8_LAS unsigned char* lds, const Gemm g, const Sched& S, const Epi& E) {
    int tid_l = threadIdx.x; asm volatile("" : "+v"(tid_l));
    const int tid = tid_l, wid = __builtin_amdgcn_readfirstlane(tid >> 6), lane = tid & 63, wr = wid >> 2, wc = wid & 3, fr = lane & 15, fq = lane >> 4;
    const int K = g.K, nt = K / BK;
    unsigned voffA[2], voffB[2];
#pragma unroll
    for (int i = 0; i < 2; ++i) { int R, C; stage_rc(tid * 16 + i * 8192, R, C); const int Rb = Epi::PERM ? ((R & ~31) + perm32(R & 31)) : R;
        voffA[i] = (unsigned)(R * K + C) * 2u; voffB[i] = (unsigned)(Rb * K + C) * 2u; }
    const size_t kstep = (size_t)(BK * 2);
    const size_t hstep = (size_t)HALF * K * 2;
    const size_t tstep = 2 * hstep;
    const unsigned ldsw = (unsigned)wid * 1024u;
    const int aoff = lds_byte(wr * 64 + fr, fq * 8), boff = lds_byte(wc * 32 + fr, fq * 8);
#define PG8_SA(b, h) (((b) * 2 + (h)) * HTB)
#define PG8_SB(b, h) ((4 + (b) * 2 + (h)) * HTB)
#define PG8_STAGE(bufoff, gbase, voff) do { _Pragma("unroll") for (int _i = 0; _i < 2; ++_i) \
        __builtin_amdgcn_global_load_lds((const unsigned*)((const char*)(gbase) + (voff)[_i]), (PG8_LAS unsigned*)(lds + (bufoff) + ldsw + _i * 8192), 16, 0, 0); } while (0)
#define PG8_LDA(dst, b, h) do { _Pragma("unroll") for (int m = 0; m < 4; ++m) _Pragma("unroll") for (int k = 0; k < 2; ++k) dst[m][k] = *(const PG8_LAS bf16x8*)(lds + PG8_SA(b, h) + aoff + m * 2048 + k * 1024); } while (0)
#define PG8_LDB(dst, b, h) do { _Pragma("unroll") for (int n = 0; n < 2; ++n) _Pragma("unroll") for (int k = 0; k < 2; ++k) dst[n][k] = *(const PG8_LAS bf16x8*)(lds + PG8_SB(b, h) + boff + n * 2048 + k * 1024); } while (0)
#define PG8_MMA(ai, bj, At, Bt) do { __builtin_amdgcn_s_setprio(1); _Pragma("unroll") for (int m = 0; m < 4; ++m) _Pragma("unroll") for (int n = 0; n < 2; ++n) _Pragma("unroll") for (int k = 0; k < 2; ++k) \
        acc[ai][bj][m][n] = __builtin_amdgcn_mfma_f32_16x16x32_bf16(Bt[n][k], At[m][k], acc[ai][bj][m][n], 0, 0, 0); __builtin_amdgcn_s_setprio(0); } while (0)
#define PG8_WAIT_V(n) asm volatile("s_waitcnt vmcnt(" #n ")" ::: "memory")
#define PG8_WAIT_L(n) asm volatile("s_waitcnt lgkmcnt(" #n ")" ::: "memory")
#define PG8_BAR __builtin_amdgcn_s_barrier()
#define PG8_SCHED __builtin_amdgcn_sched_barrier(0)
    Unit cur, nxt; int ui = 0;
    if (!S.next(0, cur)) return;
    f32x4 acc[2][2][4][2];
#pragma unroll
    for (int a = 0; a < 2; ++a)
#pragma unroll
        for (int b = 0; b < 2; ++b)
#pragma unroll
            for (int m = 0; m < 4; ++m)
#pragma unroll
                for (int n = 0; n < 2; ++n) acc[a][b][m][n] = (f32x4){0.f, 0.f, 0.f, 0.f};
    bf16x8 At[4][2], B0[2][2], B1[2][2];
    const char* cA = (const char*)g.A + S.a_off(cur) + (size_t)cur.pm * tstep; const char* cB = (const char*)g.Bt + (size_t)cur.pn * tstep;
    S.a_ready(cur);
    if constexpr (SP2) {
        PG8_STAGE(PG8_SB(0, 0), cB, voffB); PG8_STAGE(PG8_SB(0, 1), cB + hstep, voffB); PG8_STAGE(PG8_SA(0, 0), cA, voffA); PG8_STAGE(PG8_SA(0, 1), cA + hstep, voffA);
        if (wr == 1) PG8_BAR;
        PG8_WAIT_V(2); PG8_BAR;
        PG8_STAGE(PG8_SB(1, 0), cB + kstep, voffB); PG8_STAGE(PG8_SA(1, 0), cA + kstep, voffA); PG8_STAGE(PG8_SB(1, 1), cB + hstep + kstep, voffB);
        PG8_WAIT_V(6); PG8_BAR;
    } else {
        PG8_STAGE(PG8_SB(0, 0), cB, voffB); PG8_STAGE(PG8_SA(0, 0), cA, voffA); PG8_STAGE(PG8_SB(0, 1), cB + hstep, voffB); PG8_STAGE(PG8_SA(0, 1), cA + hstep, voffA);
        if (wr == 1) PG8_BAR;
        PG8_WAIT_V(4); PG8_BAR;
        PG8_STAGE(PG8_SB(1, 0), cB + kstep, voffB); PG8_STAGE(PG8_SA(1, 0), cA + kstep, voffA); PG8_STAGE(PG8_SB(1, 1), cB + hstep + kstep, voffB);
        PG8_WAIT_V(6); PG8_BAR;
    }
    for (;;) {
        const bool has_next = S.next(ui + 1, nxt);
        const char* nA = has_next ? (const char*)g.A + S.a_off(nxt) + (size_t)nxt.pm * tstep : cA; const char* nB = has_next ? (const char*)g.Bt + (size_t)nxt.pn * tstep : cB;
        for (int t = 0; t < nt; t += 2) {
            const bool last = (t == nt - 2);
            const char* a1 = cA + (size_t)(t + 1) * kstep;
            const char* a2 = last ? nA : cA + (size_t)(t + 2) * kstep; const char* b2 = last ? nB : cB + (size_t)(t + 2) * kstep;
            const char* a3 = a2 + kstep; const char* b3 = b2 + kstep;
            if (last && has_next) S.a_ready(nxt);
            if constexpr (SP2) {
            PG8_LDB(B0, 0, 0); PG8_LDB(B1, 0, 1); PG8_SCHED; PG8_LDA(At, 0, 0); PG8_STAGE(PG8_SA(1, 1), a1 + hstep, voffA);
            PG8_WAIT_V(8); PG8_WAIT_L(0); PG8_BAR; PG8_MMA(0, 0, At, B0); PG8_MMA(0, 1, At, B1); PG8_BAR; PG8_SCHED;
            PG8_LDA(At, 0, 1); PG8_STAGE(PG8_SB(0, 0), b2, voffB); PG8_STAGE(PG8_SB(0, 1), b2 + hstep, voffB); PG8_STAGE(PG8_SA(0, 0), a2, voffA);
            PG8_WAIT_V(8); PG8_WAIT_L(0); PG8_BAR; PG8_MMA(1, 0, At, B0); PG8_MMA(1, 1, At, B1); PG8_BAR; PG8_SCHED;
            PG8_LDB(B0, 1, 0); PG8_LDB(B1, 1, 1); PG8_SCHED; PG8_LDA(At, 1, 0); PG8_STAGE(PG8_SA(0, 1), a2 + hstep, voffA);
            PG8_WAIT_V(8); PG8_WAIT_L(0); PG8_BAR; PG8_MMA(0, 0, At, B0); PG8_MMA(0, 1, At, B1); PG8_BAR; PG8_SCHED;
            PG8_LDA(At, 1, 1); PG8_STAGE(PG8_SB(1, 0), b3, voffB); PG8_STAGE(PG8_SB(1, 1), b3 + hstep, voffB); PG8_STAGE(PG8_SA(1, 0), a3, voffA);
            PG8_WAIT_V(8); PG8_WAIT_L(0); PG8_BAR; PG8_MMA(1, 0, At, B0); PG8_MMA(1, 1, At, B1); PG8_BAR; PG8_SCHED;
            } else {
            PG8_LDB(B0, 0, 0); PG8_SCHED; PG8_LDA(At, 0, 0); PG8_STAGE(PG8_SA(1, 1), a1 + hstep, voffA);
            PG8_WAIT_L(8); PG8_BAR; PG8_WAIT_L(0); PG8_MMA(0, 0, At, B0); PG8_BAR; PG8_SCHED;
            PG8_LDB(B1, 0, 1); PG8_STAGE(PG8_SB(0, 0), b2, voffB);
            PG8_BAR; PG8_WAIT_L(0); PG8_MMA(0, 1, At, B1); PG8_BAR;
            PG8_LDA(At, 0, 1); PG8_STAGE(PG8_SA(0, 0), a2, voffA);
            PG8_BAR; PG8_WAIT_L(0); PG8_MMA(1, 0, At, B0); PG8_BAR; PG8_SCHED;
            PG8_STAGE(PG8_SB(0, 1), b2 + hstep, voffB);
            PG8_WAIT_V(6); PG8_BAR; PG8_MMA(1, 1, At, B1); PG8_BAR;
            PG8_LDB(B0, 1, 0); PG8_SCHED; PG8_LDA(At, 1, 0); PG8_STAGE(PG8_SA(0, 1), a2 + hstep, voffA);
            PG8_WAIT_L(8); PG8_BAR; PG8_WAIT_L(0); PG8_MMA(0, 0, At, B0); PG8_BAR; PG8_SCHED;
            PG8_LDB(B1, 1, 1); PG8_STAGE(PG8_SB(1, 0), b3, voffB);
            PG8_BAR; PG8_WAIT_L(0); PG8_MMA(0, 1, At, B1); PG8_BAR;
            PG8_LDA(At, 1, 1); PG8_STAGE(PG8_SA(1, 0), a3, voffA);
            PG8_BAR; PG8_WAIT_L(0); PG8_MMA(1, 0, At, B0); PG8_BAR; PG8_SCHED;
            PG8_STAGE(PG8_SB(1, 1), b3 + hstep, voffB);
            PG8_WAIT_V(6); PG8_BAR; PG8_MMA(1, 1, At, B1); PG8_BAR;
            }
        }
        if constexpr (ALIGN_EPI) { if (wr == 0) PG8_BAR; }
        if constexpr (!Epi::AFTER_DRAIN) { E(acc, cur, wr, wc, fr, fq); S.done(cur); }
        if (!has_next) break;
#pragma unroll
        for (int a = 0; a < 2; ++a)
#pragma unroll
            for (int b = 0; b < 2; ++b)
#pragma unroll
                for (int m = 0; m < 4; ++m)
#pragma unroll
                    for (int n = 0; n < 2; ++n) acc[a][b][m][n] = (f32x4){0.f, 0.f, 0.f, 0.f};
        cur = nxt; cA = nA; cB = nB; ++ui;
        if constexpr (ALIGN_EPI) { if (wr == 1) PG8_BAR; }
    }
    PG8_WAIT_V(0);
    if constexpr (!ALIGN_EPI) { if (wr == 0) PG8_BAR; }
    PG8_BAR;
    if constexpr (Epi::AFTER_DRAIN) { E.fused(acc, cur, wr, wc, fr, fq, lds, wid, lane); S.done(cur); }
#undef PG8_SA
#undef PG8_SB
#undef PG8_STAGE
#undef PG8_LDA
#undef PG8_LDB
#undef PG8_MMA
#undef PG8_WAIT_V
#undef PG8_WAIT_L
#undef PG8_BAR
#undef PG8_SCHED
}
}
#define XB_TMO      128
#define XB_XCNT(j)  (256  + 64 * (j))
#define XB_XSUB(j)  (1280 + 64 * (j))
#define XB_XGEN(j)  (2304 + 64 * (j))
#define XB_TOP      3328
#define XB_TOPGEN   3392
#define XCD_BAR_WORDS 3456
#define XB_SPIN_CAP (1u << 18)

__device__ __forceinline__ unsigned xb_ld(unsigned* p)              { return __hip_atomic_load(p, __ATOMIC_RELAXED, __HIP_MEMORY_SCOPE_AGENT); }
__device__ __forceinline__ unsigned xb_add(unsigned* p, unsigned v) { return __hip_atomic_fetch_add(p, v, __ATOMIC_RELAXED, __HIP_MEMORY_SCOPE_AGENT); }
__device__ __forceinline__ unsigned xb_xcc_id() { return (unsigned)__builtin_amdgcn_s_getreg((3 << 11) | 20) & 0xFu; }
#define XB_SPIN(cond, bar) do { unsigned _sp = 0; while (cond) { __builtin_amdgcn_s_sleep(1); \
    if ((++_sp & 255u) == 0u) { if (xb_ld(&(bar)[XB_TMO])) break; if (_sp > XB_SPIN_CAP) { atomicAdd(&(bar)[XB_TMO], 1u); break; } } } } while (0)

struct XcdBarrier {
    unsigned* bar; unsigned x;
    volatile LAS unsigned* st;
};

__device__ __forceinline__ XcdBarrier xcd_barrier_post(unsigned* bar, volatile LAS unsigned* st) {
    XcdBarrier b; b.bar = bar; b.x = xb_xcc_id(); b.st = st;
    if (threadIdx.x == 0) (void)xb_add(&bar[XB_XCNT(b.x)], 1u);
    return b;
}
__device__ __forceinline__ void xcd_barrier_complete(unsigned* bar, unsigned x, unsigned& nloc, unsigned& nx) {
    const unsigned G = gridDim.x * gridDim.y * gridDim.z;
    unsigned sum, cnt, mine, sp = 0u;
    for (;;) {
        sum = 0u; cnt = 0u; mine = 0u;
#pragma unroll
        for (unsigned j = 0; j < 16; ++j) { const unsigned c = xb_ld(&bar[XB_XCNT(j)]); sum += c; cnt += (c > 0u) ? 1u : 0u; mine = (j == x) ? c : mine; }
        if (sum == G) break;
        __builtin_amdgcn_s_sleep(1);
        if ((++sp & 255u) == 0u) { if (xb_ld(&bar[XB_TMO])) break; if (sp > XB_SPIN_CAP) { atomicAdd(&bar[XB_TMO], 1u); break; } }
    }
    nloc = mine > 0u ? mine : 1u; nx = cnt > 0u ? cnt : 1u;
}

__device__ __forceinline__ void xcd_barrier(const XcdBarrier& b) {
    asm volatile("s_waitcnt vmcnt(0)" ::: "memory");
    __syncthreads();
    if (threadIdx.x == 0) {
        unsigned* bar = b.bar;
        __builtin_amdgcn_s_waitcnt(0);
        unsigned nloc = b.st[0], nx = b.st[1];
        if (nloc == 0u) { xcd_barrier_complete(bar, b.x, nloc, nx); b.st[0] = nloc; b.st[1] = nx; }
        const unsigned old = xb_add(&bar[XB_XSUB(b.x)], 1u);
        const unsigned gen = old / nloc;
        if (old + 1u == (gen + 1u) * nloc) {
            __builtin_amdgcn_fence(__ATOMIC_RELEASE, "agent");
            asm volatile("s_waitcnt vmcnt(0)" ::: "memory");
            const unsigned og = xb_add(&bar[XB_TOP], 1u);
            const unsigned tg = og / nx;
            if (og + 1u == (tg + 1u) * nx) xb_add(&bar[XB_TOPGEN], 1u);
            else XB_SPIN(xb_ld(&bar[XB_TOPGEN]) == tg, bar);
            __builtin_amdgcn_fence(__ATOMIC_ACQUIRE, "agent");
            xb_add(&bar[XB_XGEN(b.x)], 1u);
            asm volatile("s_waitcnt vmcnt(0)" ::: "memory");
        } else {
            XB_SPIN(xb_ld(&bar[XB_XGEN(b.x)]) == gen, bar);
            __builtin_amdgcn_fence(__ATOMIC_ACQUIRE, "agent");
            asm volatile("s_waitcnt vmcnt(0)" ::: "memory");
        }
    }
    __syncthreads();
}

struct Frame {
    LAS unsigned char* lds;
    volatile LAS unsigned* MISC;
    gu32* ctl;
    int wave, vcu, G;
    unsigned char* ws;
};
#ifdef PROBE_LO
struct Params { const float* in[25]; float* out; unsigned char* ws; int ph_lo, ph_hi; int rerun, rsv; };
#define RCOEF(c) (kargs()->rerun ? 0.f : (c))
#else
struct Params { const float* in[25]; float* out; unsigned char* ws; int ph_lo, ph_hi; };
#define RCOEF(c) (c)
#endif
__device__ __forceinline__ const CAS Params* kargs() { const CAS Params* q = (const CAS Params*)__builtin_amdgcn_kernarg_segment_ptr(); asm volatile("" : "+s"(q)); return q; }
#define KIN(i) ((const float*)kargs()->in[i])
enum { I_X = 0, I_C, I_T5, I_ADAW, I_ADAB, I_NORMG, I_FWI, I_FWO, I_WIN, I_CKVG, I_WUK, I_WUV, I_MU, I_W0, I_W2, I_A0, I_A2, I_G2, I_KK, I_KA, I_RK, I_LNW, I_LNB, I_WOUT, I_FNG };

template <class Map>
__device__ __forceinline__ void conv_load(float (&v)[32], int it, int nblk, const float* src, int ld_src, int Ks, const Map& map, int lane_) {
    const int kb = it / nblk, nb = it % nblk; float sc = 1.f; const int scol = map(32 * nb + (lane_ & 31), sc);
    const unsigned loff = (unsigned)((lane_ >> 5) * ld_src + (scol < 0 ? 0 : scol));
#pragma unroll
    for (int i = 0; i < 32; ++i) { const int ku = 64 * kb + 2 * i; const int kc = ku < Ks ? ku : Ks - 2; v[i] = (src + (size_t)kc * ld_src)[loff]; }
}
template <class Map>
__device__ __forceinline__ void conv_proc(const float (&v)[32], int it, int nblk, int Ks, LAS float* scr, bf16* dst, int ldd, const Map& map, int lane_) {
    const int kb = it / nblk, nb = it % nblk, k0 = 64 * kb, n0 = 32 * nb; float sc = 1.f; const int scol = map(n0 + (lane_ & 31), sc); if (scol < 0) sc = 0.f;
#pragma unroll
    for (int i = 0; i < 32; ++i) scr[(2 * i + (lane_ >> 5)) * 33 + (lane_ & 31)] = v[i] * ((k0 + 2 * i < Ks) ? sc : 0.f);
    LDS_WAIT(); asm volatile("" ::: "memory");
    const int c = lane_ & 7;
#pragma unroll
    for (int j = 0; j < 4; ++j) { const int n = (lane_ >> 3) + 8 * j; const LAS float* s = scr + (8 * c) * 33 + n;
        v4u o; o.x = pk2(s[0 * 33], s[1 * 33]); o.y = pk2(s[2 * 33], s[3 * 33]); o.z = pk2(s[4 * 33], s[5 * 33]); o.w = pk2(s[6 * 33], s[7 * 33]);
        *(GAS v4u*)(dst + (size_t)(n0 + n) * ldd + k0 + 8 * c) = o; }
    LDS_WAIT(); asm volatile("" ::: "memory");
}
template <class Map>
__device__ __forceinline__ void convT(const Frame& F, const float* src, int ld_src, int Ks, int Kd, bf16* dst, int Nd, int ldd, const Map map, int& rot) {
    const int lane_ = ltid() & 63;
    LAS float* scr = (LAS float*)(F.lds + F.wave * 16384);
    const int NGW = F.G * NWAVES; int gw = F.vcu * NWAVES + F.wave - rot; if (gw < 0) gw += NGW;
    const int nblk = Nd / 32, nitems = (Kd / 64) * nblk;
    rot = (rot + nitems) % NGW;
    float va[32], vb[32];
    if (gw < nitems) conv_load(va, gw, nblk, src, ld_src, Ks, map, lane_);
    for (int it = gw; it < nitems; it += 2 * NGW) {
        const int i1 = it + NGW, i2 = i1 + NGW;
        if (i1 < nitems) conv_load(vb, i1, nblk, src, ld_src, Ks, map, lane_);
        conv_proc(va, it, nblk, Ks, scr, dst, ldd, map, lane_);
        if (i2 < nitems) conv_load(va, i2, nblk, src, ld_src, Ks, map, lane_);
        if (i1 < nitems) conv_proc(vb, i1, nblk, Ks, scr, dst, ldd, map, lane_);
    }
}
struct MapId { __device__ __forceinline__ int operator()(int n, float&) const { return n; } };
struct MapFfnIn { __device__ __forceinline__ int operator()(int n, float&) const { return ((n & 128) ? FF : 0) + (n >> 8) * 128 + (n & 127); } };
struct MapWin {
    __device__ __forceinline__ int operator()(int n, float& sc) const { const int zc = 2048 + n;
        if (zc < ZC_WL) { if (zc >= ZC_WIDX) sc = 0.03125f; return zc - 2048 + 1024; }
        if (zc < 3856) return 5456 + (zc - ZC_WL);
        if (zc < ZC_R) return -1;
        return 2384 + (zc - ZC_R); } };

__device__ __forceinline__ void p0a_prologue(Frame& F) {
    const int tid_ = ltid(), lane_ = tid_ & 63;
    const int gw = F.vcu * NWAVES + F.wave, NGW = F.G * NWAVES;
    const size_t gt = (size_t)gw * 64 + lane_, NGT = (size_t)NGW * 64;
    unsigned char* ws = F.ws;
    {
        LAS float* cact = (LAS float*)F.lds;
        LAS float* red = (LAS float*)(F.lds + 32768);
        for (int i = tid_; i < BATCH * D; i += NTHR) { const float cv = KIN(I_C)[i]; cact[i] = cv / (1.0f + __expf(-cv)); }
        __syncthreads();
        float* mod = (float*)(ws + WS_MOD);
        const int ntask = DEPTH * (NMOD / 128);
        for (int task = F.vcu; task < ntask; task += F.G) {
            const int l = task / (NMOD / 128), c0 = (task % (NMOD / 128)) * 128;
            const float* W = KIN(I_ADAW) + (size_t)l * D * NMOD + c0 + 4 * (lane_ & 31);
            f32x4 a[4] = {{0.f, 0.f, 0.f, 0.f}, {0.f, 0.f, 0.f, 0.f}, {0.f, 0.f, 0.f, 0.f}, {0.f, 0.f, 0.f, 0.f}};
            const int kbase = F.wave * 256 + (lane_ >> 5);
#pragma unroll 16
            for (int i = 0; i < 128; ++i) { const int k = kbase + 2 * i; const f32x4 w = *(const GAS f32x4*)(W + (size_t)k * NMOD);
#pragma unroll
                for (int b = 0; b < 4; ++b) a[b] += w * cact[b * D + k]; }
#pragma unroll
            for (int b = 0; b < 4; ++b) {
#pragma unroll
                for (int j = 0; j < 4; ++j) a[b][j] += __shfl_xor(a[b][j], 32);
                if (lane_ < 32) *(LAS f32x4*)(red + (F.wave * 4 + b) * 128 + 4 * lane_) = a[b]; }
            __syncthreads();
            { const int b = tid_ >> 7, c = tid_ & 127; float s = 0.f;
#pragma unroll
              for (int w = 0; w < 8; ++w) s += red[(w * 4 + b) * 128 + c];
              mod[((size_t)l * BATCH + b) * NMOD + c0 + c] = s + KIN(I_ADAB)[(size_t)l * NMOD + c0 + c]; }
            __syncthreads();
        }
        __syncthreads();
    }
    int rot = 0;
    for (int li = 0; li < 2 * DEPTH; ++li) {
        convT(F, KIN(I_FWI) + (size_t)li * D * NFI, NFI, D, D, (bf16*)(ws + WS_WFI + li * WFI_ONE), NFI, D, MapFfnIn(), rot);
        convT(F, KIN(I_FWO) + (size_t)li * FF * D, D, FF, FF, (bf16*)(ws + WS_WFO + li * WFO_ONE), D, FF, MapId(), rot);
    }
    for (int l = 0; l < DEPTH; ++l) {
        convT(F, KIN(I_WIN) + (size_t)l * D * PIN, PIN, D, D, (bf16*)(ws + WS_WIN + l * WIN_ONE) + (size_t)2048 * D, NZ - 2048, D, MapWin(), rot);
        convT(F, KIN(I_WOUT) + (size_t)l * D * D + (size_t)1024 * D, D, 1024, 1024, (bf16*)(ws + WS_WOUT + l * WOUT_ONE) + 2048, D, KO, MapId(), rot);
        convT(F, KIN(I_WOUT) + (size_t)l * D * D, D, 1024, 1024, (bf16*)(ws + WS_WOUTTA + l * 4 * MiB), D, 1024, MapId(), rot);
        convT(F, KIN(I_W2) + (size_t)l * 96 * 1024, 1024, 96, 256, (bf16*)(ws + WS_WLORA + (l * 3 + 0) * WLORA_ONE), 1024, 256, MapId(), rot);
        convT(F, KIN(I_A2) + (size_t)l * 96 * 1024, 1024, 96, 256, (bf16*)(ws + WS_WLORA + (l * 3 + 1) * WLORA_ONE), 1024, 256, MapId(), rot);
        convT(F, KIN(I_G2) + (size_t)l * 256 * 1024, 1024, 256, 256, (bf16*)(ws + WS_WLORA + (l * 3 + 2) * WLORA_ONE), 1024, 256, MapId(), rot);
        const float* win = KIN(I_WIN) + (size_t)l * D * PIN; bf16* winq = (bf16*)(ws + WS_WINQ + l * 4 * MiB);
        const float* wuk = KIN(I_WUK) + (size_t)l * 256 * 1024; const float* wuv = KIN(I_WUV) + (size_t)l * 256 * 1024;
        bf16* bduk = (bf16*)(ws + WS_BDUK + l * 4 * MiB); bf16* bduv = (bf16*)(ws + WS_BDUV + l * 4 * MiB);
        for (size_t e = gt; e < (size_t)2048 * 128; e += NGT) {
            const int row = (int)(e >> 7), c8 = (int)(e & 127) * 8;
            { const float* s = win + (size_t)row * PIN + c8; const f32x4 a = *(const GAS f32x4*)s, b = *(const GAS f32x4*)(s + 4);
              v4u o; o.x = pk2(a.x, a.y); o.y = pk2(a.z, a.w); o.z = pk2(b.x, b.y); o.w = pk2(b.z, b.w); *(GAS v4u*)(winq + (size_t)row * 1024 + c8) = o; }
            const int h = row >> 8, r = row & 255, hp = c8 >> 7;
            v4u ok = {0u, 0u, 0u, 0u}, ov = {0u, 0u, 0u, 0u};
            if (h == hp) { const float qs = 0.08838834764831845f;
                const float* s = wuk + (size_t)r * 1024 + c8; const f32x4 a = *(const GAS f32x4*)s * qs, b = *(const GAS f32x4*)(s + 4) * qs;
                ok.x = pk2(a.x, a.y); ok.y = pk2(a.z, a.w); ok.z = pk2(b.x, b.y); ok.w = pk2(b.z, b.w);
                const float* t = wuv + (size_t)r * 1024 + c8; const f32x4 c = *(const GAS f32x4*)t, d = *(const GAS f32x4*)(t + 4);
                ov.x = pk2(c.x, c.y); ov.y = pk2(c.z, c.w); ov.z = pk2(d.x, d.y); ov.w = pk2(d.z, d.w); }
            *(GAS v4u*)(bduk + (size_t)row * 1024 + c8) = ok; *(GAS v4u*)(bduv + (size_t)row * 1024 + c8) = ov;
        }
    }
}

__device__ __forceinline__ float row_sumsq(const f32x4 (&v)[8]) { float s = 0.f;
#pragma unroll
    for (int j = 0; j < 8; ++j) s += (v[j].x * v[j].x + v[j].y * v[j].y) + (v[j].z * v[j].z + v[j].w * v[j].w);
    return wave_sum(s); }
__device__ __forceinline__ void adaln_phase(const Frame& F, const float* h, const float* g, const float* modl  , int sub, bf16* hn) {
    const int lane_ = ltid() & 63;
    const int gw = F.vcu * NWAVES + F.wave, NGW = F.G * NWAVES;
    for (int grp = gw; grp < M / 8; grp += NGW) {
        const int m0 = grp * 8, b = m0 >> 12;
        const float* sh = modl + (size_t)b * NMOD + (sub * 3 + 0) * D; const float* scl = sh + D;
        f32x4 ga[8], sb[8];
#pragma unroll
        for (int j = 0; j < 8; ++j) { const int c = 4 * lane_ + 256 * j; ga[j] = *(const GAS f32x4*)(g + c) * (*(const GAS f32x4*)(scl + c) + 1.0f); sb[j] = *(const GAS f32x4*)(sh + c); }
        const GAS f32x4* xr = (const GAS f32x4*)(h + (size_t)m0 * D) + lane_; GAS v2u* o8 = (GAS v2u*)(hn + (size_t)m0 * D) + lane_;
        f32x4 va[8], vb[8];
#define AL_LOAD(v, r) { _Pragma("unroll") for (int j = 0; j < 8; ++j) v[j] = xr[(size_t)(r) * (D / 4) + 64 * j]; }
#define AL_PROC(v, r) { const float rstd = 1.0f / sqrtf(row_sumsq(v) * (1.0f / D) + RMS_EPS); \
            _Pragma("unroll") for (int j = 0; j < 8; ++j) { const f32x4 y = v[j] * rstd * ga[j] + sb[j]; v2u o; o.x = pk2(y.x, y.y); o.y = pk2(y.z, y.w); o8[(size_t)(r) * (D / 4) + 64 * j] = o; } }
        AL_LOAD(va, 0)
#pragma unroll 1
        for (int r = 0; r < 8; r += 2) { AL_LOAD(vb, r + 1) AL_PROC(va, r) if (r + 2 < 8) AL_LOAD(va, r + 2) AL_PROC(vb, r + 1) }
#undef AL_LOAD
#undef AL_PROC
    }
}

__device__ __forceinline__ void final_norm_phase(const Frame& F, float* out, const float* g) {
    const int lane_ = ltid() & 63;
    const int gw = F.vcu * NWAVES + F.wave, NGW = F.G * NWAVES;
    for (int grp = gw; grp < M / 8; grp += NGW) {
        f32x4 gg[8];
#pragma unroll
        for (int j = 0; j < 8; ++j) gg[j] = *(const GAS f32x4*)(g + 4 * lane_ + 256 * j);
        GAS f32x4* xr = (GAS f32x4*)(out + (size_t)grp * 8 * D) + lane_;
        f32x4 va[8], vb[8];
#define FN_LOAD(v, r) { _Pragma("unroll") for (int j = 0; j < 8; ++j) v[j] = xr[(size_t)(r) * (D / 4) + 64 * j]; }
#define FN_PROC(v, r) { const float rstd = 1.0f / sqrtf(row_sumsq(v) * (1.0f / D) + RMS_EPS); \
            _Pragma("unroll") for (int j = 0; j < 8; ++j) xr[(size_t)(r) * (D / 4) + 64 * j] = v[j] * rstd * gg[j]; }
        FN_LOAD(va, 0)
#pragma unroll 1
        for (int r = 0; r < 8; r += 2) { FN_LOAD(vb, r + 1) FN_PROC(va, r) if (r + 2 < 8) FN_LOAD(va, r + 2) FN_PROC(vb, r + 1) }
#undef FN_LOAD
#undef FN_PROC
    }
}

__device__ __forceinline__ float row_sumsq_h(const v4u (&v)[4]) { float s = 0.f;
#pragma unroll
    for (int j = 0; j < 4; ++j) { float x[8]; x[0] = bflo(v[j].x); x[1] = bfhi(v[j].x); x[2] = bflo(v[j].y); x[3] = bfhi(v[j].y); x[4] = bflo(v[j].z); x[5] = bfhi(v[j].z); x[6] = bflo(v[j].w); x[7] = bfhi(v[j].w);
        s += ((x[0] * x[0] + x[1] * x[1]) + (x[2] * x[2] + x[3] * x[3])) + ((x[4] * x[4] + x[5] * x[5]) + (x[6] * x[6] + x[7] * x[7])); }
    return wave_sum(s); }
__device__ __forceinline__ void adaln_phase_h(const Frame& F, const bf16* h, const float* g, const float* modl  , int sub, bf16* hn) {
    const int lane_ = ltid() & 63;
    const int gw = F.vcu * NWAVES + F.wave, NGW = F.G * NWAVES;
    for (int grp = gw; grp < M / 8; grp += NGW) {
        const int m0 = grp * 8, b = m0 >> 12;
        const float* sh = modl + (size_t)b * NMOD + (sub * 3 + 0) * D; const float* scl = sh + D;
        const GAS v4u* xr = (const GAS v4u*)(h + (size_t)m0 * D) + lane_; GAS v4u* o8 = (GAS v4u*)(hn + (size_t)m0 * D) + lane_;
        v4u va[4][4], vb[4][4];
#pragma unroll
        for (int r = 0; r < 4; ++r)
#pragma unroll
            for (int j = 0; j < 4; ++j) va[r][j] = xr[(size_t)r * (D / 8) + 64 * j];
#pragma unroll
        for (int r = 0; r < 4; ++r)
#pragma unroll
            for (int j = 0; j < 4; ++j) vb[r][j] = xr[(size_t)(r + 4) * (D / 8) + 64 * j];
        f32x4 ga[4][2], sb[4][2];
#pragma unroll
        for (int j = 0; j < 4; ++j)
#pragma unroll
            for (int n = 0; n < 2; ++n) { const int c = 8 * lane_ + 512 * j + 4 * n; ga[j][n] = *(const GAS f32x4*)(g + c) * (*(const GAS f32x4*)(scl + c) + 1.0f); sb[j][n] = *(const GAS f32x4*)(sh + c); }
#define ALH_PROC(v, r) { const float rstd = 1.0f / sqrtf(row_sumsq_h(v) * (1.0f / D) + RMS_EPS); \
            _Pragma("unroll") for (int j = 0; j < 4; ++j) { const v4u w = v[j]; \
                const f32x4 x0 = {bflo(w.x), bfhi(w.x), bflo(w.y), bfhi(w.y)}, x1 = {bflo(w.z), bfhi(w.z), bflo(w.w), bfhi(w.w)}; \
                const f32x4 y0 = x0 * rstd * ga[j][0] + sb[j][0], y1 = x1 * rstd * ga[j][1] + sb[j][1]; \
                v4u o; o.x = pk2(y0.x, y0.y); o.y = pk2(y0.z, y0.w); o.z = pk2(y1.x, y1.y); o.w = pk2(y1.z, y1.w); o8[(size_t)(r) * (D / 8) + 64 * j] = o; } }
#pragma unroll
        for (int r = 0; r < 4; ++r) ALH_PROC(va[r], r)
#pragma unroll
        for (int r = 0; r < 4; ++r) ALH_PROC(vb[r], r + 4)
#undef ALH_PROC
    }
}
__device__ __forceinline__ void final_norm_phase_h(const Frame& F, const bf16* h, float* out, const float* g) {
    const int lane_ = ltid() & 63;
    const int gw = F.vcu * NWAVES + F.wave, NGW = F.G * NWAVES;
    for (int grp = gw; grp < M / 8; grp += NGW) {
        const GAS v4u* xr = (const GAS v4u*)(h + (size_t)grp * 8 * D) + lane_; GAS f32x4* orow = (GAS f32x4*)(out + (size_t)grp * 8 * D) + 2 * lane_;
        v4u va[4][4], vb[4][4];
#pragma unroll
        for (int r = 0; r < 4; ++r)
#pragma unroll
            for (int j = 0; j < 4; ++j) va[r][j] = xr[(size_t)r * (D / 8) + 64 * j];
#pragma unroll
        for (int r = 0; r < 4; ++r)
#pragma unroll
            for (int j = 0; j < 4; ++j) vb[r][j] = xr[(size_t)(r + 4) * (D / 8) + 64 * j];
        f32x4 gg[4][2];
#pragma unroll
        for (int j = 0; j < 4; ++j)
#pragma unroll
            for (int n = 0; n < 2; ++n) gg[j][n] = *(const GAS f32x4*)(g + 8 * lane_ + 512 * j + 4 * n);
#define FNH_PROC(v, r) { const float rstd = 1.0f / sqrtf(row_sumsq_h(v) * (1.0f / D) + RMS_EPS); \
            _Pragma("unroll") for (int j = 0; j < 4; ++j) { const v4u w = v[j]; \
                const f32x4 x0 = {bflo(w.x), bfhi(w.x), bflo(w.y), bfhi(w.y)}, x1 = {bflo(w.z), bfhi(w.z), bflo(w.w), bfhi(w.w)}; \
                orow[(size_t)(r) * (D / 4) + 128 * j] = x0 * rstd * gg[j][0]; orow[(size_t)(r) * (D / 4) + 128 * j + 1] = x1 * rstd * gg[j][1]; } }
#pragma unroll
        for (int r = 0; r < 4; ++r) FNH_PROC(va[r], r)
#pragma unroll
        for (int r = 0; r < 4; ++r) FNH_PROC(vb[r], r + 4)
#undef FNH_PROC
    }
}

__device__ __forceinline__ void unpack8(const v4u w, float (&x)[8]) { x[0] = bflo(w.x); x[1] = bfhi(w.x); x[2] = bflo(w.y); x[3] = bfhi(w.y); x[4] = bflo(w.z); x[5] = bfhi(w.z); x[6] = bflo(w.w); x[7] = bfhi(w.w); }
__device__ __forceinline__ v4u pack8(const float (&x)[8]) { v4u o; o.x = pk2(x[0], x[1]); o.y = pk2(x[2], x[3]); o.z = pk2(x[4], x[5]); o.w = pk2(x[6], x[7]); return o; }

__device__ __forceinline__ void prep_phase(const Frame& F, const bf16* __restrict__ Z, const float* __restrict__ mu, const float* __restrict__ ckvg, bf16* __restrict__ LA, bf16* __restrict__ CKV) {
    const int gw = F.vcu * NWAVES + F.wave, NGW = F.G * NWAVES, lane = ltid() & 63;
    const int l5 = lane & 31, j0 = 8 * l5, hf = lane >> 5;
    for (int grp = gw; grp < M / 8; grp += NGW) {
        const int r0 = grp * 8 + 4 * hf;
        const bool hp = (r0 & (SEQ - 1)) != 0;
        const bf16* zb = Z + (size_t)r0 * NZ;
        v4u zw[3][5], cw[4];
#pragma unroll
        for (int which = 0; which < 3; ++which) {
            const int zcol = which == 0 ? ZC_WL : (which == 1 ? ZC_AL : ZC_GL), nval = which == 2 ? 256 : 96;
#pragma unroll
            for (int i = 0; i < 5; ++i) { zw[which][i] = (v4u){0u, 0u, 0u, 0u}; if (j0 < nval && (i > 0 || hp)) zw[which][i] = *(const GAS v4u*)(zb + (ptrdiff_t)(i - 1) * NZ + zcol + j0); } }
#pragma unroll
        for (int i = 0; i < 4; ++i) cw[i] = *(const GAS v4u*)(zb + (size_t)i * NZ + ZC_CKV + j0);
#pragma unroll
        for (int which = 0; which < 3; ++which) {
            const int moff = which == 0 ? 3072 : (which == 1 ? 3168 : 3264), nval = which == 2 ? 256 : 96;
            float mv[8];
#pragma unroll
            for (int j = 0; j < 8; ++j) mv[j] = (j0 < nval) ? mu[moff + j0 + j] : 0.f;
#pragma unroll
            for (int i = 0; i < 4; ++i) {
                float y[8] = {0.f, 0.f, 0.f, 0.f, 0.f, 0.f, 0.f, 0.f};
                if (j0 < nval) { float cc[8], pp[8]; unpack8(zw[which][i + 1], cc); unpack8(zw[which][i], pp);
#pragma unroll
                    for (int j = 0; j < 8; ++j) { const float zm = cc[j] + (pp[j] - cc[j]) * mv[j];
                        if (which == 0) { const float e = __expf(-2.0f * fabsf(zm)); const float th = (1.0f - e) / (1.0f + e); y[j] = zm < 0.f ? -th : th; }
                        else if (which == 1) y[j] = zm;
                        else y[j] = 1.0f / (1.0f + __expf(-zm)); } }
                *(GAS v4u*)(LA + (size_t)which * M * 256 + (size_t)(r0 + i) * 256 + j0) = pack8(y); }
        }
        {
            float gv[8];
#pragma unroll
            for (int j = 0; j < 8; ++j) gv[j] = ckvg[j0 + j];
#pragma unroll
            for (int i = 0; i < 4; ++i) { float cc[8]; unpack8(cw[i], cc);
                float ss = 0.f;
#pragma unroll
                for (int j = 0; j < 8; ++j) ss += cc[j] * cc[j];
#pragma unroll
                for (int o = 1; o < 32; o <<= 1) ss += __shfl_xor(ss, o);
                const float rstd = 1.0f / sqrtf(ss * (1.0f / 256.0f) + RMS_EPS);
                float y[8];
#pragma unroll
                for (int j = 0; j < 8; ++j) y[j] = cc[j] * rstd * gv[j];
                *(GAS v4u*)(CKV + (size_t)(r0 + i) * 256 + j0) = pack8(y); }
        }
    }
}

__device__ __forceinline__ float wave_sum_f(float x) {
    x += __builtin_bit_cast(float, __builtin_amdgcn_update_dpp(0, __builtin_bit_cast(int, x), 0xB1, 0xF, 0xF, true));
    x += __builtin_bit_cast(float, __builtin_amdgcn_update_dpp(0, __builtin_bit_cast(int, x), 0x4E, 0xF, 0xF, true));
    x += __builtin_bit_cast(float, __builtin_amdgcn_update_dpp(0, __builtin_bit_cast(int, x), 0x141, 0xF, 0xF, true));
    x += __builtin_bit_cast(float, __builtin_amdgcn_update_dpp(0, __builtin_bit_cast(int, x), 0x140, 0xF, 0xF, true));
    const int xi = __builtin_bit_cast(int, x);
    return (__builtin_bit_cast(float, __builtin_amdgcn_readlane(xi, 0)) + __builtin_bit_cast(float, __builtin_amdgcn_readlane(xi, 16))) +
           (__builtin_bit_cast(float, __builtin_amdgcn_readlane(xi, 32)) + __builtin_bit_cast(float, __builtin_amdgcn_readlane(xi, 48)));
}
__device__ __forceinline__ unsigned wave_sum_u(unsigned x) {
    x += (unsigned)__builtin_amdgcn_update_dpp(0, (int)x, 0xB1, 0xF, 0xF, true);
    x += (unsigned)__builtin_amdgcn_update_dpp(0, (int)x, 0x4E, 0xF, 0xF, true);
    x += (unsigned)__builtin_amdgcn_update_dpp(0, (int)x, 0x141, 0xF, 0xF, true);
    x += (unsigned)__builtin_amdgcn_update_dpp(0, (int)x, 0x140, 0xF, 0xF, true);
    return (unsigned)__builtin_amdgcn_readlane((int)x, 0) + (unsigned)__builtin_amdgcn_readlane((int)x, 16) + (unsigned)__builtin_amdgcn_readlane((int)x, 32) + (unsigned)__builtin_amdgcn_readlane((int)x, 48);
}
__device__ __forceinline__ unsigned wave_incl_scan(unsigned x) {
    x += (unsigned)__builtin_amdgcn_update_dpp(0, (int)x, 0x111, 0xF, 0xF, false);
    x += (unsigned)__builtin_amdgcn_update_dpp(0, (int)x, 0x112, 0xF, 0xF, false);
    x += (unsigned)__builtin_amdgcn_update_dpp(0, (int)x, 0x114, 0xF, 0xF, false);
    x += (unsigned)__builtin_amdgcn_update_dpp(0, (int)x, 0x118, 0xF, 0xF, false);
    x += (unsigned)__builtin_amdgcn_update_dpp(0, (int)x, 0x142, 0xA, 0xF, false);
    x += (unsigned)__builtin_amdgcn_update_dpp(0, (int)x, 0x143, 0xC, 0xF, false);
    return x;
}
__device__ __forceinline__ unsigned fkey(float f) { const unsigned u = __builtin_bit_cast(unsigned, f); return (u & 0x80000000u) ? ~u : (u | 0x80000000u); }
template <int REP_SC, int REP_SEL>
__device__ __forceinline__ void topk_phase(const Frame& F, const bf16* __restrict__ Z, unsigned short* __restrict__ IDX) {
    LAS float* SC = (LAS float*)F.lds;
    const int lane = ltid() & 63, w = F.wave, hl = lane >> 5, ln = lane & 31;
    const int qq = (ln >> 2) & 1, hh = (ln & 3) + 4 * (ln >> 3);
    const unsigned long long lt_mask = (1ull << lane) - 1ull;
    bf16x8 A[4][4]; v4u wp[4][2];
#define TK_LOAD_Q(m0_) { _Pragma("unroll") for (int mt = 0; mt < 4; ++mt) { \
            _Pragma("unroll") for (int ks = 0; ks < 4; ++ks) A[mt][ks] = *(const GAS bf16x8*)(Z + (size_t)((m0_) + 2 * mt + qq) * NZ + ZC_QIDX + hh * 64 + 16 * ks + 8 * hl); } }
    if (F.vcu < M / 8) TK_LOAD_Q(F.vcu * 8)
    for (int ui = 0; ui * F.G < M / 8; ++ui) {
        const int unit = ui * F.G + ((ui & 1) ? (F.G - 1 - F.vcu) : F.vcu);
        if (unit >= M / 8) break;
        const int m0 = unit * 8, t0 = m0 & (SEQ - 1);
        const bf16* Zb = Z + (size_t)(m0 - t0) * NZ;
#pragma unroll
        for (int mt = 0; mt < 4; ++mt) { wp[mt][0] = *(const GAS v4u*)(Z + (size_t)(m0 + 2 * mt + hl) * NZ + ZC_WIDX); wp[mt][1] = *(const GAS v4u*)(Z + (size_t)(m0 + 2 * mt + hl) * NZ + ZC_WIDX + 8); }
        const int nkt = (t0 + 7) / 32 + 1;
        for (int rep_sc = 0; rep_sc < REP_SC; ++rep_sc) {
            const bool extra = rep_sc > 0;
            constexpr bool X_NOLOAD = (REPK == 63 || REPK == 66), X_NOMMA = (REPK == 64 || REPK == 65), X_NOEPI = (REPK == 65);
            bf16x8 Bn[4];
            if (w < nkt) { const bf16* kp = Zb + (size_t)(w * 32 + ln) * NZ + ZC_KIDX + 8 * hl;
#pragma unroll
                for (int ks = 0; ks < 4; ++ks) Bn[ks] = *(const GAS bf16x8*)(kp + 16 * ks); }
            unsigned sink = 0u;
            for (int kt = w; kt < nkt; kt += NWAVES) {
                bf16x8 Bf[4];
#pragma unroll
                for (int ks = 0; ks < 4; ++ks) Bf[ks] = Bn[ks];
                if (kt + NWAVES < nkt && !(extra && X_NOLOAD)) { const bf16* kp = Zb + (size_t)((kt + NWAVES) * 32 + ln) * NZ + ZC_KIDX + 8 * hl;
#pragma unroll
                    for (int ks = 0; ks < 4; ++ks) Bn[ks] = *(const GAS bf16x8*)(kp + 16 * ks); }
                if (extra && X_NOEPI) {
#pragma unroll
                    for (int ks = 0; ks < 4; ++ks) sink ^= (unsigned)Bf[ks][0];
                    continue; }
                if (extra && REPK == 66) {
                    unsigned xs[8];
#pragma unroll
                    for (int i = 0; i < 8; ++i) xs[i] = (unsigned)Bf[i & 3][i >> 2] + sink;
#pragma unroll
                    for (int r = 0; r < 32; ++r) {
#pragma unroll
                        for (int i = 0; i < 8; ++i) { xs[i] ^= (unsigned)kt; xs[i] += 0x9e3779b9u + (unsigned)lane; } }
#pragma unroll
                    for (int i = 0; i < 8; ++i) sink ^= xs[i];
                    continue; }
#pragma unroll
                for (int mt = 0; mt < 4; ++mt) {
                    f32x16 acc;
#pragma unroll
                    for (int i = 0; i < 16; ++i) acc[i] = 0.f;
                    if (!(extra && X_NOMMA)) {
#pragma unroll
                        for (int ks = 0; ks < 4; ++ks) acc = __builtin_amdgcn_mfma_f32_32x32x16_bf16(A[mt][ks], Bf[ks], acc, 0, 0, 0);
                    } else { acc[0] = __builtin_bit_cast(float, (unsigned)Bf[mt][1] << 16); acc[5] = __builtin_bit_cast(float, (unsigned)Bf[mt][2] << 16); }
                    float s = 0.f;
                    typedef short s16x2 __attribute__((ext_vector_type(2)));
#pragma unroll
                    for (int p2 = 0; p2 < 8; ++p2) { const unsigned pk = pk2(acc[2 * p2], acc[2 * p2 + 1]);
                        const s16x2 rl = __builtin_elementwise_max(__builtin_bit_cast(s16x2, pk), (s16x2){0, 0});
                        const unsigned wv = wp[mt][p2 >> 2][p2 & 3];
                        s = __builtin_amdgcn_fdot2_f32_bf16(__builtin_bit_cast(hwbf2, rl), __builtin_bit_cast(hwbf2, wv), s, false); }
                    if (extra && REPK != 61) ((LAS float*)(F.lds + 131072))[lane] = s; else SC[(2 * mt + hl) * SEQ + kt * 32 + ln] = s;
                }
            }
            if (extra && (X_NOEPI || REPK == 66)) ((LAS unsigned*)(F.lds + 131072))[lane] = sink;
        }
        __syncthreads();
        { const int un_ = (ui + 1) * F.G + (((ui + 1) & 1) ? (F.G - 1 - F.vcu) : F.vcu); if ((ui + 1) * F.G < M / 8 && un_ < M / 8) TK_LOAD_Q(un_ * 8) }
        for (int rep_sel = 0; rep_sel < REP_SEL; ++rep_sel)
        {
            const int m = m0 + w, nv = t0 + w + 1;
            unsigned u[64];
#pragma unroll
            for (int i = 0; i < 64; ++i) u[i] = __builtin_bit_cast(unsigned, SC[w * SEQ + lane + 64 * i]);
#pragma unroll
            for (int i = 0; i < 64; ++i) { const unsigned x = u[i]; const unsigned kx = (x & 0x80000000u) ? ~x : (x | 0x80000000u); u[i] = (lane + 64 * i < nv) ? (kx >> 1) : 0u; }
            unsigned T = 1u; int need_eq = 0;
            if (nv > TOPK) {
                T = 0u; bool exact = false;
                const int nreg = (nv > 3072) ? 64 : (nv > 2048 ? 48 : (nv > 1024 ? 32 : 16));
                for (int bit = 30; bit >= 0; --bit) {
                    const unsigned cand = T | (1u << bit); unsigned clt = 0u;
#pragma unroll
                    for (int g4 = 0; g4 < 4; ++g4) if (g4 * 1024 < nv) { unsigned acc = 0u;
#pragma unroll
                        for (int i = 16 * g4; i < 16 * g4 + 16; ++i) acc = __builtin_amdgcn_alignbit(acc, u[i] - cand, 31);
                        clt += (unsigned)__popc(acc); }
                    const int cnt = 64 * nreg - (int)wave_sum_u(clt);
                    if (cnt >= TOPK) { T = cand; if (cnt == TOPK) { exact = true; break; } }
                }
                if (exact) { T -= 1u; need_eq = 0; }
                else { unsigned c = 0u;
#pragma unroll
                    for (int i = 0; i < 64; ++i) c += (u[i] > T) ? 1u : 0u;
                    need_eq = TOPK - (int)wave_sum_u(c); }
            }
            LAS unsigned short* stage = (LAS unsigned short*)(SC + w * SEQ);
            int base = 0;
            if (need_eq == 0) {
#pragma unroll
                for (int g4 = 0; g4 < 4; ++g4) if (g4 * 1024 < nv) {
#pragma unroll
                    for (int i = 16 * g4; i < 16 * g4 + 16; ++i) {
                        const bool sel = u[i] > T; const unsigned long long ms = __ballot(sel);
                        const int pos = base + (int)__builtin_amdgcn_mbcnt_hi((unsigned)(ms >> 32), __builtin_amdgcn_mbcnt_lo((unsigned)ms, 0u));
                        if (sel) stage[pos] = (unsigned short)(lane + 64 * i);
                        base += __popcll(ms);
                    } }
            } else {
                int eqseen = 0;
#pragma unroll
                for (int g4 = 0; g4 < 4; ++g4) if (g4 * 1024 < nv) {
#pragma unroll
                    for (int i = 16 * g4; i < 16 * g4 + 16; ++i) {
                        const bool gt = u[i] > T, eq = (u[i] == T);
                        const unsigned long long meq = __ballot(eq);
                        const int eqr = eqseen + __popcll(meq & lt_mask);
                        const bool sel = gt || (eq && eqr < need_eq);
                        const unsigned long long ms = __ballot(sel);
                        const int pos = base + __popcll(ms & lt_mask);
                        if (sel && pos < TOPK) stage[pos] = (unsigned short)(lane + 64 * i);
                        base += __popcll(ms); eqseen += __popcll(meq);
                    } }
            }
            for (int p = base + lane; p < TOPK; p += 64) stage[p] = (unsigned short)0xFFFFu;
            LDS_WAIT();
            *(GAS v2u*)(IDX + (size_t)m * TOPK + 4 * lane) = *(const LAS v2u*)(stage + 4 * lane);
        }
        __syncthreads();
    }
}

#undef TK_LOAD_Q
template <int OFF> __device__ __forceinline__ bf16x4 tr_read4(unsigned lds_addr) { bf16x4 r; asm volatile("ds_read_b64_tr_b16 %0, %1 offset:%2\n\ts_waitcnt lgkmcnt(0)" : "=&v"(r) : "v"(lds_addr), "n"(OFF) : "memory"); return r; }
constexpr int AT_BP = 1056, AT_IDX = 16 * AT_BP, AT_TILE = AT_IDX + 1024, AT_TB = SCR_BYTES + 1024, AT_LUT = AT_TB + 1024;
static_assert(NWAVES * AT_TILE <= SCR_BYTES && AT_LUT + 132 <= LDS_BYTES && MISC_OFF + 128 <= AT_TB, "attention LDS");
__device__ __forceinline__ float xrow_max(float x) {
    const unsigned xi = __builtin_bit_cast(unsigned, x); const auto a = __builtin_amdgcn_permlane16_swap(xi, xi, false, false);
    const float m = fmaxf(__builtin_bit_cast(float, a[0]), __builtin_bit_cast(float, a[1])); const unsigned mi = __builtin_bit_cast(unsigned, m);
    const auto b = __builtin_amdgcn_permlane32_swap(mi, mi, false, false); return fmaxf(__builtin_bit_cast(float, b[0]), __builtin_bit_cast(float, b[1])); }
__device__ __forceinline__ float xrow_sum(float x) {
    const unsigned xi = __builtin_bit_cast(unsigned, x); const auto a = __builtin_amdgcn_permlane16_swap(xi, xi, false, false);
    const float m = __builtin_bit_cast(float, a[0]) + __builtin_bit_cast(float, a[1]); const unsigned mi = __builtin_bit_cast(unsigned, m);
    const auto b = __builtin_amdgcn_permlane32_swap(mi, mi, false, false); return __builtin_bit_cast(float, b[0]) + __builtin_bit_cast(float, b[1]); }
__device__ __forceinline__ void attn_setup(const Frame& F, const float* t5) {
    LAS float* tb = (LAS float*)(F.lds + AT_TB); LAS unsigned char* lut = F.lds + AT_LUT;
    for (int i = ltid(); i < 256; i += NTHR) tb[i] = t5[i];
    for (int n = ltid(); n < 132; n += NTHR) {
        int bk = n; if (n >= 16) { bk = 16 + (int)(__log2f((float)n * 0.0625f) * 5.33333333f); bk = bk > 31 ? 31 : bk; }
        lut[n] = (unsigned char)bk; }
    __syncthreads();
}
__device__ __forceinline__ void attn_phase(const Frame& F, const bf16* __restrict__ Z, const bf16* __restrict__ CKV, const unsigned short* __restrict__ IDX, const float* __restrict__ t5, bf16* __restrict__ O, unsigned* __restrict__ wq) {
    LAS unsigned char* tile = F.lds + F.wave * AT_TILE;
    LAS unsigned short* idxl = (LAS unsigned short*)(tile + AT_IDX);
    LAS float* tb = (LAS float*)(F.lds + AT_TB); const LAS unsigned char* lut = F.lds + AT_LUT;
    LAS unsigned short* idxs = idxl + 256;
    const int lane = ltid() & 63, g = lane >> 4, i16 = lane & 15, q = i16 >> 2, p = i16 & 3, hd = i16 & 7, half = lane >> 5;
    const unsigned tbase = (unsigned)(size_t)tile;
    const int sh0 = (int)(xb_xcc_id() & 7u);
    for (int ss = 0; ss < 8; ++ss) {
      const int shard = (sh0 + ss) & 7;
      for (;;) {
        int item = 0; if (lane == 0) item = (int)__hip_atomic_fetch_add(wq + 64 * shard, 1u, RLX_AGENT);
        item = __builtin_amdgcn_readfirstlane(item);
        if (item >= M / 8) break;
        const int m = shard * (M / 8) + item;
        const int t = m & (SEQ - 1); const size_t brow = (size_t)(m - t);
        { const v2u iv = *(const GAS v2u*)(IDX + (size_t)m * TOPK + 4 * lane); *(LAS v2u*)(idxl + 4 * lane) = iv;
          v2u sv; sv.x = (((iv.x & 0xFFFFu) == 0xFFFFu) ? 0u : (iv.x & 0xFFFFu)) | (((iv.x >> 16) == 0xFFFFu) ? 0u : (iv.x & 0xFFFF0000u));
          sv.y = (((iv.y & 0xFFFFu) == 0xFFFFu) ? 0u : (iv.y & 0xFFFFu)) | (((iv.y >> 16) == 0xFFFFu) ? 0u : (iv.y & 0xFFFF0000u));
          *(LAS v2u*)(idxs + 4 * lane) = sv; }
        bf16x8 qf[8];
#pragma unroll
        for (int ks = 0; ks < 8; ++ks) { const bf16x8 v = *(const GAS bf16x8*)(Z + (size_t)m * NZ + hd * 256 + 32 * ks + 8 * g); qf[ks] = (i16 < 8) ? v : (bf16x8){0, 0, 0, 0, 0, 0, 0, 0}; }
        f32x4 oacc[16];
#pragma unroll
        for (int c = 0; c < 16; ++c) oacc[c] = (f32x4){0.f, 0.f, 0.f, 0.f};
        float mrun = -INFINITY, lrun = 0.f;
        const bf16* gb = CKV + brow * 256 + (lane & 31) * 8;
        LDS_WAIT();
#define AT_GATHER(chv) { const v4u i0_ = *(const LAS v4u*)(idxs + (chv) * 32 + 16 * half), i1_ = *(const LAS v4u*)(idxs + (chv) * 32 + 16 * half + 8); \
            const unsigned iw_[8] = {i0_.x, i0_.y, i0_.z, i0_.w, i1_.x, i1_.y, i1_.z, i1_.w}; \
            _Pragma("unroll") for (int j = 0; j < 16; ++j) { const unsigned kid_ = (j & 1) ? (iw_[j >> 1] >> 16) : (iw_[j >> 1] & 0xFFFFu); \
                __builtin_amdgcn_global_load_lds((const unsigned*)(gb + ((size_t)kid_ << 8)), (LAS unsigned*)(tile + j * AT_BP), 16, 0, 0); } }
        AT_GATHER(0)
        for (int ch = 0; ch < 8; ++ch) {
            asm volatile("s_waitcnt vmcnt(0)" ::: "memory");
            f32x4 lg[2];
#pragma unroll
            for (int mt = 0; mt < 2; ++mt) { f32x4 a_ = {0.f, 0.f, 0.f, 0.f};
#pragma unroll
                for (int ks = 0; ks < 8; ++ks) { const bf16x8 cf = *(const LAS bf16x8*)(tile + i16 * AT_BP + 512 * mt + 64 * ks + 16 * g); a_ = __builtin_amdgcn_mfma_f32_16x16x32_bf16(cf, qf[ks], a_, 0, 0, 0); }
                lg[mt] = a_; }
            bf16x8 pv[16];
            const unsigned trb = tbase + (unsigned)((4 * g + q) * AT_BP + 8 * p);
#define AT_TR4(c0) { bf16x4 l0, h0, l1, h1, l2, h2, l3, h3; \
                asm volatile("ds_read_b64_tr_b16 %0, %8 offset:%9\n\tds_read_b64_tr_b16 %1, %8 offset:%10\n\tds_read_b64_tr_b16 %2, %8 offset:%11\n\tds_read_b64_tr_b16 %3, %8 offset:%12\n\t" \
                             "ds_read_b64_tr_b16 %4, %8 offset:%13\n\tds_read_b64_tr_b16 %5, %8 offset:%14\n\tds_read_b64_tr_b16 %6, %8 offset:%15\n\tds_read_b64_tr_b16 %7, %8 offset:%16\n\ts_waitcnt lgkmcnt(0)" \
                             : "=&v"(l0), "=&v"(h0), "=&v"(l1), "=&v"(h1), "=&v"(l2), "=&v"(h2), "=&v"(l3), "=&v"(h3) \
                             : "v"(trb), "n"(32 * (c0)), "n"(512 + 32 * (c0)), "n"(32 * ((c0) + 1)), "n"(512 + 32 * ((c0) + 1)), "n"(32 * ((c0) + 2)), "n"(512 + 32 * ((c0) + 2)), "n"(32 * ((c0) + 3)), "n"(512 + 32 * ((c0) + 3)) : "memory"); \
                pv[(c0)] = __builtin_shufflevector(l0, h0, 0, 1, 2, 3, 4, 5, 6, 7); pv[(c0) + 1] = __builtin_shufflevector(l1, h1, 0, 1, 2, 3, 4, 5, 6, 7); \
                pv[(c0) + 2] = __builtin_shufflevector(l2, h2, 0, 1, 2, 3, 4, 5, 6, 7); pv[(c0) + 3] = __builtin_shufflevector(l3, h3, 0, 1, 2, 3, 4, 5, 6, 7); }
            AT_TR4(0) AT_TR4(4) AT_TR4(8) AT_TR4(12)
#undef AT_TR4
            if (ch < 7) AT_GATHER(ch + 1)
            float pr[2][4]; float cm = -INFINITY;
#pragma unroll
            for (int mt = 0; mt < 2; ++mt) { const v2u iw = *(const LAS v2u*)(idxl + ch * 32 + 16 * mt + 4 * g);
#pragma unroll
                for (int r = 0; r < 4; ++r) { const unsigned kv = ((r & 2) ? iw.y : iw.x) >> ((r & 1) * 16) & 0xFFFFu;
                    const unsigned dist = (unsigned)(t - (int)kv);
                    const unsigned bk = lut[dist < 128u ? dist : 128u];
                    float x = lg[mt][r] + tb[bk * 8 + hd];
                    x = (kv == 0xFFFFu) ? -INFINITY : x;
                    pr[mt][r] = x; cm = fmaxf(cm, x); } }
            cm = fmaxf(cm, __shfl_xor(cm, 16)); cm = fmaxf(cm, __shfl_xor(cm, 32));
            const float mnew = fmaxf(mrun, cm);
            const float alpha = __expf(mrun - mnew);
            float ls = 0.f;
#pragma unroll
            for (int mt = 0; mt < 2; ++mt)
#pragma unroll
                for (int r = 0; r < 4; ++r) { const float e = __expf(pr[mt][r] - mnew); pr[mt][r] = e; ls += e; }
            ls += __shfl_xor(ls, 16); ls += __shfl_xor(ls, 32);
            lrun = lrun * alpha + ls; mrun = mnew;
            v4u pw; pw.x = pk2(pr[0][0], pr[0][1]); pw.y = pk2(pr[0][2], pr[0][3]); pw.z = pk2(pr[1][0], pr[1][1]); pw.w = pk2(pr[1][2], pr[1][3]);
            const bf16x8 pf = __builtin_bit_cast(bf16x8, pw);
            if (__builtin_amdgcn_readfirstlane(__ballot(alpha != 1.0f) != 0ull)) {
#pragma unroll
                for (int c = 0; c < 16; ++c) oacc[c] = oacc[c] * alpha; }
#pragma unroll
            for (int c = 0; c < 16; ++c) oacc[c] = __builtin_amdgcn_mfma_f32_16x16x32_bf16(pv[c], pf, oacc[c], 0, 0, 0);
        }
#undef AT_GATHER
        const float inv = 1.0f / lrun;
        if (i16 < 8) {
            bf16* op = O + (size_t)m * KO + hd * 256 + 4 * g;
#pragma unroll
            for (int c = 0; c < 16; ++c) { v2u o; o.x = pk2(oacc[c][0] * inv, oacc[c][1] * inv); o.y = pk2(oacc[c][2] * inv, oacc[c][3] * inv); *(GAS v2u*)(op + 16 * c) = o; }
        }
      }
    }
}

constexpr int CP = 144;
constexpr int CSLOT = 64 * CP;
constexpr int S_A = 0, S_B = 1, S_K = 2, S_R = 3, S_V = 4, S_LAK = 5, S_MBR = 6, S_MKR = 7, S_T = 8, S_TH = 9, S_PH = 10, S_L = 11, S_TB = 12, S_LA = 13, S_LB = 14, S_G2 = S_B, S_OM = S_MBR;
constexpr int C_GC = 15 * CSLOT;
static_assert(C_GC + 256 + 2048 <= SCR_BYTES, "chunk phase LDS");
__device__ __forceinline__ bf16x8 rowfrag(LAS unsigned char* slot, int tile, int ks, int ln, int hl) { return *(const LAS bf16x8*)(slot + (32 * tile + ln) * CP + 32 * ks + 16 * hl); }
__device__ __forceinline__ void trfrag4(unsigned a, bf16x8 (&f)[4]) {
    bf16x4 l0, h0, l1, h1, l2, h2, l3, h3;
    asm volatile("ds_read_b64_tr_b16 %0, %8 offset:%9\n\tds_read_b64_tr_b16 %1, %8 offset:%10\n\tds_read_b64_tr_b16 %2, %8 offset:%11\n\tds_read_b64_tr_b16 %3, %8 offset:%12\n\t"
                 "ds_read_b64_tr_b16 %4, %8 offset:%13\n\tds_read_b64_tr_b16 %5, %8 offset:%14\n\tds_read_b64_tr_b16 %6, %8 offset:%15\n\tds_read_b64_tr_b16 %7, %8 offset:%16\n\ts_waitcnt lgkmcnt(0)"
                 : "=&v"(l0), "=&v"(h0), "=&v"(l1), "=&v"(h1), "=&v"(l2), "=&v"(h2), "=&v"(l3), "=&v"(h3)
                 : "v"(a), "n"(0), "n"(4 * CP), "n"(16 * CP), "n"(20 * CP), "n"(32 * CP), "n"(36 * CP), "n"(48 * CP), "n"(52 * CP) : "memory");
    f[0] = __builtin_shufflevector(l0, h0, 0, 1, 2, 3, 4, 5, 6, 7); f[1] = __builtin_shufflevector(l1, h1, 0, 1, 2, 3, 4, 5, 6, 7);
    f[2] = __builtin_shufflevector(l2, h2, 0, 1, 2, 3, 4, 5, 6, 7); f[3] = __builtin_shufflevector(l3, h3, 0, 1, 2, 3, 4, 5, 6, 7);
}
__device__ __forceinline__ unsigned trbase(LAS unsigned char* slot, int tile, int lane) { const int hl = lane >> 5, blk = (lane >> 4) & 1, q = (lane & 15) >> 2, p = lane & 3;
    return (unsigned)(size_t)slot + (unsigned)((8 * hl + q) * CP + 64 * tile + 32 * blk + 8 * p); }
template <int AM, int BM> __device__ __forceinline__ f32x16 mm_tile(LAS unsigned char* sa, int ta, LAS unsigned char* sb, int tb, f32x16 acc, int lane) {
    const int ln = lane & 31, hl = lane >> 5;
    const unsigned tra = trbase(sa, ta, lane), trb = trbase(sb, tb, lane);
    bf16x8 a[4], b[4];
    if constexpr (BM == 0) {
#pragma unroll
        for (int ks = 0; ks < 4; ++ks) b[ks] = rowfrag(sb, tb, ks, ln, hl);
    }
    if constexpr (AM == 0) {
#pragma unroll
        for (int ks = 0; ks < 4; ++ks) a[ks] = rowfrag(sa, ta, ks, ln, hl);
    } else trfrag4(tra, a);
    if constexpr (BM != 0) trfrag4(trb, b);
#pragma unroll
    for (int ks = 0; ks < 4; ++ks) acc = __builtin_amdgcn_mfma_f32_32x32x16_bf16(a[ks], b[ks], acc, 0, 0, 0);
    return acc;
}
__device__ __forceinline__ int crow32(int reg, int hl) { return (reg & 3) + 8 * (reg >> 2) + 4 * hl; }
__device__ __forceinline__ void tile_store_T(LAS unsigned char* slot, int rt, int ct, const f32x16& v, int lane) {
    const int ln = lane & 31, hl = lane >> 5;
#pragma unroll
    for (int q4 = 0; q4 < 4; ++q4) { v2u o; o.x = pk2(v[4 * q4], v[4 * q4 + 1]); o.y = pk2(v[4 * q4 + 2], v[4 * q4 + 3]);
        *(LAS v2u*)(slot + (32 * ct + ln) * CP + (32 * rt + 8 * q4 + 4 * hl) * 2) = o; }
}
__device__ __forceinline__ f32x16 tile_load_T(LAS unsigned char* slot, int rt, int ct, int lane) {
    const int ln = lane & 31, hl = lane >> 5; f32x16 v;
#pragma unroll
    for (int q4 = 0; q4 < 4; ++q4) { const v2u o = *(const LAS v2u*)(slot + (32 * ct + ln) * CP + (32 * rt + 8 * q4 + 4 * hl) * 2);
        v[4 * q4] = bflo(o.x); v[4 * q4 + 1] = bfhi(o.x); v[4 * q4 + 2] = bflo(o.y); v[4 * q4 + 3] = bfhi(o.y); }
    return v;
}
__device__ __forceinline__ f32x16 zero16() { f32x16 v;
#pragma unroll
    for (int r = 0; r < 16; ++r) v[r] = 0.f;
    return v; }

template <int REPC>
__device__ __forceinline__ void chunk_phase(const Frame& F, const bf16* __restrict__ Z, const bf16* __restrict__ LAp, const bf16* __restrict__ WLp, const float* __restrict__ w0v, const float* __restrict__ a0v, const float* __restrict__ mu, const float* __restrict__ k_k, const float* __restrict__ k_a, const float* __restrict__ r_k,
                                            bf16* __restrict__ RHO, bf16* __restrict__ ZL, bf16* __restrict__ PT, bf16* __restrict__ QT, float* __restrict__ BON) {
    const int lane = ltid() & 63, ln = lane & 31, hl = lane >> 5;
#define WL() int w = F.wave; asm volatile("" : "+s"(w))
    LAS unsigned char* L = F.lds;
#define SLOT(s) (L + (s) * CSLOT)
    LAS float* GC = (LAS float*)(L + C_GC);
    float zr[9], zk[9], zv[9]; bf16x8 lfa[6], lfb[6];
#define CH_LOAD(tk) { const int b_ = (tk) >> 10, h_ = ((tk) >> 6) & 15, c_ = (tk) & 63; int w_ = F.wave; asm volatile("" : "+s"(w_)); const int t0w_ = 8 * w_, hc_ = h_ * 64 + lane; \
        const int tok_ = b_ * SEQ + c_ * CH; const bf16* zrow_ = Z + (size_t)(tok_ + t0w_) * NZ + hc_; \
        _Pragma("unroll") for (int q = 0; q < 9; ++q) { const bool ok_ = (q > 0) || (c_ * CH + t0w_ > 0); const bf16* rp_ = zrow_ + (ptrdiff_t)(q - 1) * NZ; \
            zr[q] = 0.f; zk[q] = 0.f; zv[q] = 0.f; if (ok_) { zr[q] = bf2f(rp_[ZC_R]); zk[q] = bf2f(rp_[ZC_K]); zv[q] = bf2f(rp_[ZC_V]); } } \
        const int mm_ = w_ >> 2, rt_ = (w_ >> 1) & 1, ct_ = w_ & 1; \
        const bf16* ap_ = LAp + (size_t)mm_ * M * 256 + (size_t)(tok_ + 32 * rt_ + ln) * 256 + 8 * hl; const bf16* bp_ = WLp + (size_t)mm_ * 1024 * 256 + (size_t)(h_ * 64 + 32 * ct_ + ln) * 256 + 8 * hl; \
        _Pragma("unroll") for (int ks = 0; ks < 6; ++ks) { lfa[ks] = *(const GAS bf16x8*)(ap_ + 16 * ks); lfb[ks] = *(const GAS bf16x8*)(bp_ + 16 * ks); } }
    if (F.vcu < BATCH * 16 * NCH) CH_LOAD(F.vcu)
    for (int repc = 0; repc < REPC; ++repc)
    for (int task = F.vcu; task < BATCH * 16 * NCH; task += F.G) {
        const int b = task >> 10, h = (task >> 6) & 15, c = task & 63;
        const int tok0 = b * SEQ + c * CH;
        const size_t base = (size_t)tok0 * 1024 + h * 64;
        const size_t tbo = (size_t)task * 4096;
        LAS float* DL = (LAS float*)SLOT(8);
        {
            WL();
            const int mm = w >> 2, rt = (w >> 1) & 1, ct = w & 1; const int jc = 32 * ct + ln;
            f32x16 d = zero16();
#pragma unroll
            for (int ks = 0; ks < 6; ++ks) d = __builtin_amdgcn_mfma_f32_32x32x16_bf16(lfa[ks], lfb[ks], d, 0, 0, 0);
            const float bias = mm ? a0v[h * 64 + jc] : w0v[h * 64 + jc];
#pragma unroll
            for (int r = 0; r < 16; ++r) { const float x = d[r] + bias; float y;
                if (mm == 0) { const float nx = -x; const float sp = fmaxf(nx, 0.f) + 0.69314718056f * __builtin_amdgcn_logf(1.0f + __builtin_amdgcn_exp2f(-1.44269504089f * fabsf(nx)));
                    y = __builtin_amdgcn_exp2f(-1.44269504089f * __builtin_amdgcn_exp2f(-1.44269504089f * (sp + 0.5f))); }
                else y = __builtin_amdgcn_rcpf(1.0f + __builtin_amdgcn_exp2f(-1.44269504089f * x));
                DL[mm * 4096 + (32 * rt + crow32(r, hl)) * 64 + jc] = y; }
        }
        __syncthreads();
        {
            WL();
            const int t0w = 8 * w; const int hc = h * 64 + lane;
            const float mur = mu[hc], muk = mu[1024 + hc], muv = mu[2048 + hc], kkc = k_k[hc], kac = k_a[hc], rkc = r_k[hc];
            float wo[8], a8[8];
#pragma unroll
            for (int tt = 0; tt < 8; ++tt) { wo[tt] = DL[(t0w + tt) * 64 + lane]; a8[tt] = DL[4096 + (t0w + tt) * 64 + lane]; }
            float k8[8], b8[8], kk8[8], r8[8], v8[8]; float bonv = 0.f;
#pragma unroll
            for (int tt = 0; tt < 8; ++tt) {
                const float r = zr[tt + 1] + (zr[tt] - zr[tt + 1]) * mur, km = zk[tt + 1] + (zk[tt] - zk[tt + 1]) * muk, vv = zv[tt + 1] + (zv[tt] - zv[tt + 1]) * muv;
                const float kr = km * kkc; const float ss = wave_sum_f(kr * kr); const float kk = kr * (1.0f / fmaxf(sqrtf(ss), 1e-12f));
                const float a = a8[tt]; const float kp = km * (1.0f + (a - 1.0f) * kac);
                const float bon = wave_sum_f(r * kp * rkc); bonv = (lane == tt) ? bon : bonv;
                r8[tt] = r; v8[tt] = vv; k8[tt] = kp; kk8[tt] = kk; b8[tt] = kk * a; }
            if (lane < 8) BON[(size_t)task * 64 + t0w + lane] = bonv;
            float pw = wo[0];
#pragma unroll
            for (int tt = 1; tt < 8; ++tt) pw *= wo[tt];
            LAS float* PW = (LAS float*)(L + C_GC + 256);
            PW[w * 64 + lane] = pw;
            __syncthreads();
            float g = 1.0f;
#pragma unroll
            for (int ww = 0; ww < 7; ++ww) { const float pv = PW[ww * 64 + lane]; g = (ww < w) ? g * pv : g; }
            float xa[8], xb[8], xk[8], xr[8];
#pragma unroll
            for (int tt = 0; tt < 8; ++tt) { const float gp = g; g *= wo[tt]; const float ig = __builtin_amdgcn_rcpf(g);
                xa[tt] = -gp * kk8[tt]; xb[tt] = b8[tt] * ig; xk[tt] = k8[tt] * ig; xr[tt] = r8[tt] * g; }
            *(LAS v4u*)(SLOT(S_A) + lane * CP + 16 * w) = pack8(xa); *(LAS v4u*)(SLOT(S_B) + lane * CP + 16 * w) = pack8(xb);
            *(LAS v4u*)(SLOT(S_K) + lane * CP + 16 * w) = pack8(xk); *(LAS v4u*)(SLOT(S_R) + lane * CP + 16 * w) = pack8(xr);
            *(LAS v4u*)(SLOT(S_V) + lane * CP + 16 * w) = pack8(v8);
            if (w == 7) GC[lane] = g;
            { const int nt_ = (task + F.G < BATCH * 16 * NCH) ? task + F.G : ((repc + 1 < REPC) ? F.vcu : -1); if (nt_ >= 0) CH_LOAD(nt_) }
        }
        __syncthreads();
#pragma unroll
        for (int jj = 0; jj < 2; ++jj) {
            WL();
            const int job = 2 * w + jj, mm = job >> 2, rt = (job >> 1) & 1, ct = job & 1;
            LAS unsigned char* sa = (mm & 1) ? SLOT(S_K) : SLOT(S_B); LAS unsigned char* sb = (mm & 2) ? SLOT(S_R) : SLOT(S_A);
            f32x16 d = mm_tile<1, 1>(sa, rt, sb, ct, zero16(), lane);
            const int tcol = 32 * ct + ln;
#pragma unroll
            for (int r = 0; r < 16; ++r) { const int u = 32 * rt + crow32(r, hl); const bool keep = (mm <= 1) ? (u < tcol) : (u <= tcol); d[r] = keep ? d[r] : 0.f; }
            tile_store_T((mm == 0) ? SLOT(S_L) : ((mm == 1) ? SLOT(S_LAK) : (mm == 2 ? SLOT(S_MBR) : SLOT(S_MKR))), rt, ct, d, lane);
        }
        __syncthreads();
        {
            WL();
            const int rt = (w >> 1) & 1, ct = w & 1; const bool tw = w < 4;
            f32x16 tm = zero16();
            if (tw) { tm = tile_load_T(SLOT(S_L), rt, ct, lane);
#pragma unroll
                for (int r = 0; r < 16; ++r) tm[r] += (32 * rt + crow32(r, hl) == 32 * ct + ln) ? 1.0f : 0.0f;
                tile_store_T(SLOT(S_T), rt, ct, tm, lane); }
            else { const f32x16 d = mm_tile<1, 0>(SLOT(S_L), rt, SLOT(S_L), ct, zero16(), lane); tile_store_T(SLOT(S_LA), rt, ct, d, lane); }
            __syncthreads();
#pragma unroll
            for (int st = 1; st <= 5; ++st) {
                LAS unsigned char* tin = (st & 1) ? SLOT(S_T) : SLOT(S_TB); LAS unsigned char* tout = (st & 1) ? SLOT(S_TB) : SLOT(S_T);
                LAS unsigned char* lin = (st & 1) ? SLOT(S_LA) : SLOT(S_LB); LAS unsigned char* lout = (st & 1) ? SLOT(S_LB) : SLOT(S_LA);
                if (tw) { tm = mm_tile<1, 0>(tin, rt, lin, ct, tm, lane); tile_store_T(tout, rt, ct, tm, lane); }
                else if (st < 5) { const f32x16 d = mm_tile<1, 0>(lin, rt, lin, ct, zero16(), lane); tile_store_T(lout, rt, ct, d, lane); }
                __syncthreads();
            }
        }
        {
            WL();
            const int mm = w >> 2, rt = (w >> 1) & 1, ct = w & 1;
            const f32x16 d = mm_tile<1, 0>(SLOT(S_TB), rt, mm ? SLOT(S_MBR) : SLOT(S_B), ct, zero16(), lane);
            tile_store_T(mm ? SLOT(S_PH) : SLOT(S_TH), rt, ct, d, lane);
        }
        __syncthreads();
#pragma unroll
        for (int jj = 0; jj < 2; ++jj) {
            WL();
            const int job = 2 * w + jj, mm = job >> 2, rt = (job >> 1) & 1, ct = job & 1;
            if (mm == 0) {
                f32x16 d = mm_tile<0, 0>(SLOT(S_A), rt, SLOT(S_TH), ct, zero16(), lane);
                const int jc = 32 * ct + ln; const float gc = GC[jc];
#pragma unroll
                for (int q4 = 0; q4 < 4; ++q4) { const int j0 = 32 * rt + 8 * q4 + 4 * hl; float x[4];
#pragma unroll
                    for (int e = 0; e < 4; ++e) x[e] = (d[4 * q4 + e] + ((j0 + e == jc) ? 1.0f : 0.0f)) * gc;
                    v2u o; o.x = pk2(x[0], x[1]); o.y = pk2(x[2], x[3]); *(GAS v2u*)(PT + tbo + (size_t)jc * 64 + j0) = o; }
            } else if (mm == 1) {
                const f32x16 d = mm_tile<1, 0>(SLOT(S_LAK), rt, SLOT(S_TH), ct, tile_load_T(SLOT(S_K), rt, ct, lane), lane);
                tile_store_T(SLOT(S_G2), rt, ct, d, lane);
            } else if (mm == 2) {
                const f32x16 d = mm_tile<0, 0>(SLOT(S_PH), rt, SLOT(S_A), ct, tile_load_T(SLOT(S_R), rt, ct, lane), lane);
#pragma unroll
                for (int r = 0; r < 16; ++r) RHO[(size_t)(tok0 + 32 * rt + crow32(r, hl)) * 1024 + h * 64 + 32 * ct + ln] = (bf16)f2bf(d[r]);
            } else {
                const f32x16 d = mm_tile<1, 0>(SLOT(S_LAK), rt, SLOT(S_PH), ct, tile_load_T(SLOT(S_MKR), rt, ct, lane), lane);
                tile_store_T(SLOT(S_OM), rt, ct, d, lane);
            }
        }
        __syncthreads();
        {
            WL();
            const int mm = w >> 2, rt = (w >> 1) & 1, ct = w & 1;
            const f32x16 d = mm_tile<0, 0>(SLOT(S_V), rt, mm ? SLOT(S_OM) : SLOT(S_G2), ct, zero16(), lane);
            if (mm == 0) { const int jc = 32 * ct + ln; const float gc = GC[jc];
#pragma unroll
                for (int q4 = 0; q4 < 4; ++q4) { const int i0 = 32 * rt + 8 * q4 + 4 * hl;
                    v2u o; o.x = pk2(d[4 * q4] * gc, d[4 * q4 + 1] * gc); o.y = pk2(d[4 * q4 + 2] * gc, d[4 * q4 + 3] * gc); *(GAS v2u*)(QT + tbo + (size_t)jc * 64 + i0) = o; }
            } else {
#pragma unroll
                for (int r = 0; r < 16; ++r) ZL[tbo + (size_t)(32 * rt + crow32(r, hl)) * 64 + 32 * ct + ln] = (bf16)f2bf(d[r]);
            }
        }
        __syncthreads();
    }
#undef SLOT
#undef WL
#undef CH_LOAD
}

__device__ __forceinline__ void chain_phase(const Frame& F, const bf16* __restrict__ PT, const bf16* __restrict__ QT, bf16* __restrict__ SB) {
    if ((int)blockIdx.x < BATCH * 16 && F.wave == 0) {
        const int bh = blockIdx.x, lane = ltid() & 63, hl = lane >> 5, ln = lane & 31;
        f32x16 T[2][2];
#pragma unroll
        for (int a = 0; a < 2; ++a)
#pragma unroll
            for (int b = 0; b < 2; ++b) T[a][b] = zero16();
        for (int c = 0; c < NCH; ++c) {
            const size_t tb = ((size_t)bh * NCH + c) * 4096;
            bf16x8 Bf[2][4];
#pragma unroll
            for (int it = 0; it < 2; ++it)
#pragma unroll
                for (int sp = 0; sp < 4; ++sp) { const f32x16& X = T[sp >> 1][it]; const int s = sp & 1; v4u pw;
                    pw.x = pk2(X[8 * s + 0], X[8 * s + 1]); pw.y = pk2(X[8 * s + 2], X[8 * s + 3]); pw.z = pk2(X[8 * s + 4], X[8 * s + 5]); pw.w = pk2(X[8 * s + 6], X[8 * s + 7]);
                    Bf[it][sp] = __builtin_bit_cast(bf16x8, pw);
                    bf16* sp_ = SB + tb + (size_t)(32 * it + ln) * 64 + 16 * sp + 4 * hl;
                    *(GAS v2u*)sp_ = (v2u){pw.x, pw.y}; *(GAS v2u*)(sp_ + 8) = (v2u){pw.z, pw.w}; }
            f32x16 Tn[2][2];
#pragma unroll
            for (int jt = 0; jt < 2; ++jt)
#pragma unroll
                for (int it = 0; it < 2; ++it)
#pragma unroll
                    for (int r = 0; r < 16; ++r) Tn[jt][it][r] = bf2f(QT[tb + (size_t)(32 * jt + crow32(r, hl)) * 64 + 32 * it + ln]);
#pragma unroll
            for (int jt = 0; jt < 2; ++jt)
#pragma unroll
                for (int sp = 0; sp < 4; ++sp) {
                    const bf16* ap = PT + tb + (size_t)(32 * jt + ln) * 64 + 16 * sp + 4 * hl;
                    const v2u a0 = *(const GAS v2u*)ap, a1 = *(const GAS v2u*)(ap + 8);
                    const v4u aw = {a0.x, a0.y, a1.x, a1.y}; const bf16x8 Af = __builtin_bit_cast(bf16x8, aw);
#pragma unroll
                    for (int it = 0; it < 2; ++it) Tn[jt][it] = __builtin_amdgcn_mfma_f32_32x32x16_bf16(Af, Bf[it][sp], Tn[jt][it], 0, 0, 0);
                }
#pragma unroll
            for (int jt = 0; jt < 2; ++jt)
#pragma unroll
                for (int it = 0; it < 2; ++it) T[jt][it] = Tn[jt][it];
        }
    }
}

constexpr int RO_TILE = 17408, RO_P = 65;
__device__ __forceinline__ void rwkv_out_phase(const Frame& F, const bf16* __restrict__ SB, const bf16* __restrict__ RHO, const bf16* __restrict__ ZL, const bf16* __restrict__ Z, const float* __restrict__ BON, const bf16* __restrict__ G,
                                               const float* __restrict__ mu, const float* __restrict__ ln_w, const float* __restrict__ ln_b, bf16* __restrict__ O) {
    const int gw = F.vcu * NWAVES + F.wave, NGW = F.G * NWAVES, lane = ltid() & 63, ln = lane & 31, hl = lane >> 5;
    LAS float* tile = (LAS float*)(F.lds + F.wave * RO_TILE); LAS float* bon = tile + 64 * RO_P;
    for (int task = gw; task < BATCH * 16 * NCH; task += NGW) {
        const int b = task >> 10, h = (task >> 6) & 15, c = task & 63;
        const size_t tbo = (size_t)task * 4096;
        const int tok0 = b * SEQ + c * CH;
        const size_t base = (size_t)tok0 * 1024 + h * 64;
        bon[lane] = BON[(size_t)task * 64 + lane];
        f32x16 acc[2][2];
#pragma unroll
        for (int rt = 0; rt < 2; ++rt)
#pragma unroll
            for (int ct = 0; ct < 2; ++ct)
#pragma unroll
                for (int r = 0; r < 16; ++r) acc[rt][ct][r] = bf2f(ZL[tbo + (size_t)(32 * rt + crow32(r, hl)) * 64 + 32 * ct + ln]);
#pragma unroll
        for (int ks = 0; ks < 4; ++ks) {
            bf16x8 af[2], bfr[2];
#pragma unroll
            for (int rt = 0; rt < 2; ++rt) af[rt] = *(const GAS bf16x8*)(SB + tbo + (size_t)(32 * rt + ln) * 64 + 16 * ks + 8 * hl);
#pragma unroll
            for (int ct = 0; ct < 2; ++ct) bfr[ct] = *(const GAS bf16x8*)(RHO + (size_t)(tok0 + 32 * ct + ln) * 1024 + h * 64 + 16 * ks + 8 * hl);
#pragma unroll
            for (int rt = 0; rt < 2; ++rt)
#pragma unroll
                for (int ct = 0; ct < 2; ++ct) acc[rt][ct] = __builtin_amdgcn_mfma_f32_32x32x16_bf16(af[rt], bfr[ct], acc[rt][ct], 0, 0, 0);
        }
#pragma unroll
        for (int ct = 0; ct < 2; ++ct) {
            float s1 = 0.f;
#pragma unroll
            for (int rt = 0; rt < 2; ++rt)
#pragma unroll
                for (int r = 0; r < 16; ++r) s1 += acc[rt][ct][r];
            s1 += __shfl_xor(s1, 32);
            const float mean = s1 * (1.0f / 64.0f); float s2 = 0.f;
#pragma unroll
            for (int rt = 0; rt < 2; ++rt)
#pragma unroll
                for (int r = 0; r < 16; ++r) { const float d = acc[rt][ct][r] - mean; s2 += d * d; }
            s2 += __shfl_xor(s2, 32);
            const float rstd = 1.0f / sqrtf(s2 * (1.0f / 64.0f) + GN_EPS);
#pragma unroll
            for (int rt = 0; rt < 2; ++rt)
#pragma unroll
                for (int r = 0; r < 16; ++r) tile[(32 * ct + ln) * RO_P + 32 * rt + crow32(r, hl)] = (acc[rt][ct][r] - mean) * rstd;
        }
        LDS_WAIT(); asm volatile("" ::: "memory");
        const float lw = ln_w[h * 64 + lane], lb = ln_b[h * 64 + lane], muv = mu[2048 + h * 64 + lane];
        const bf16* zvp = Z + (size_t)tok0 * NZ + ZC_V + h * 64 + lane;
        float zprev = (c > 0) ? bf2f(*(zvp - NZ)) : 0.f;
#pragma unroll 16
        for (int t = 0; t < CH; ++t) {
            const size_t o = base + (size_t)t * 1024 + lane;
            const float zcur = bf2f(zvp[(size_t)t * NZ]); const float vv = zcur + (zprev - zcur) * muv; zprev = zcur;
            const float yn = tile[t * RO_P + lane], bt = bon[t];
            const float val = (yn * lw + lb + bt * vv) * bf2f(G[o]);
            O[(size_t)(tok0 + t) * KO + 2048 + h * 64 + lane] = (bf16)f2bf(val);
        }
        LDS_WAIT(); asm volatile("" ::: "memory");
    }
}

#ifndef G_FOLD
#define G_FOLD 1
#endif
#ifndef G_FFI
#define G_FFI 1
#endif
#ifndef G_FFO
#define G_FFO 1
#endif
#ifndef G_WIN
#define G_WIN 1
#endif
#ifndef G_LORA
#define G_LORA 1
#endif
#ifndef G_WOUT
#define G_WOUT 1
#endif
#ifndef PH_TOPK
#define PH_TOPK 1
#endif
#ifndef PH_ATTN
#define PH_ATTN 1
#endif
#ifndef PH_SCAN
#define PH_SCAN 1
#endif
#ifndef PH_CHAIN
#define PH_CHAIN 1
#endif
#ifndef PH_ROUT
#define PH_ROUT 1
#endif
#ifndef PH_PREP
#define PH_PREP 1
#endif
#ifndef REPK
#define REPK -1
#endif
#ifndef MK_ONE_LAUNCH
#define MK_ONE_LAUNCH 1
#endif
#ifndef MK_LAST_PHASE
#define MK_LAST_PHASE 31
#endif
constexpr int NPHASE = 31;
#define mod ((float*)(ws + WS_MOD))
#define HN ((bf16*)(ws + WS_HN))
#define Hs ((bf16*)(ws + WS_DEC))
#define ACT ((bf16*)(ws + WS_ACT))
#define Z ((bf16*)(ws + WS_Z))
#define O ((bf16*)(ws + WS_O))
#define CKV ((bf16*)(ws + WS_CKV))
#define IDX ((unsigned short*)(ws + WS_IDX))
#define Rb ((bf16*)(ws + WS_R))
#define Vb ((bf16*)(ws + WS_V))
#define KKb ((bf16*)(ws + WS_KK))
#define Kb ((bf16*)(ws + WS_K))
#define BETAb ((bf16*)(ws + WS_BETA))
#define DECb ((float*)(ws + WS_DEC))
#define LA ((bf16*)(ws + WS_LA))
#define Gb ((bf16*)(ws + WS_G))
#define PT ((bf16*)(ws + WS_PT))
#define ST ((float*)(ws + WS_ST))
#define RHOb ((bf16*)(ws + WS_RHO))
#define SBb ((bf16*)(ws + WS_ST))
#define QT ((bf16*)(ws + WS_QT))
#define ZLOC ((bf16*)(ws + WS_ZLOC))
#define BONb ((float*)(ws + WS_K + 32 * MiB))
#define A1b ((bf16*)(ws + WS_BETA + 32 * MiB))
#define IN(k) (lo <= (k) && (k) < hi)
#define SEAM(k) do { if (IN(k) && IN((k) + 1)) { xcd_barrier(bar); if (REPK == 40) xcd_barrier(bar); } } while (0)
template <int l>
__device__ __forceinline__ void layer_phases(Frame& F, unsigned char* ws, float* out, const int lo, const int hi, const XcdBarrier& bar) {
        const int pb = 2 + 14 * l;
        const float* modl = mod + (size_t)l * BATCH * NMOD;
        const float* ng = KIN(I_NORMG) + (size_t)l * 3 * D;
        if (IN(pb + 0)) { if constexpr (l == 0) adaln_phase(F, KIN(I_X), ng, modl, 0, HN); else adaln_phase_h(F, Hs, ng, modl, 0, HN); }
        SEAM(pb + 0);
#if G_FFI
        if (IN(pb + 1)) { pg8::Gemm g{HN, (const bf16*)(ws + WS_WFI + (size_t)(2 * l) * WFI_ONE), M, NFI, D}; pg8::StaticOrder S; S.init(M, NFI, F.G, (int)blockIdx.x);
            pg8::EpiSwiglu E{ACT, FF}; pg8::gemm_phase<pg8::EpiSwiglu, pg8::StaticOrder, true, true>(F.lds, g, S, E); if (REPK == 1) { __syncthreads(); pg8::gemm_phase<pg8::EpiSwiglu, pg8::StaticOrder, true, true>(F.lds, g, S, E); } }
#endif
        SEAM(pb + 1);
#if G_FFO
        if (IN(pb + 2)) { pg8::Gemm g{ACT, (const bf16*)(ws + WS_WFO + (size_t)(2 * l) * WFO_ONE), M, D, FF}; pg8::StaticOrder S; S.init(M, D, F.G, (int)blockIdx.x, 2);
            pg8::EpiResidH<(l == 0)> E{l == 0 ? (const void*)KIN(I_X) : (const void*)Hs, Hs, D, modl + 2 * D, NMOD, RCOEF(0.5f)}; pg8::gemm_phase<pg8::EpiResidH<(l == 0)>, pg8::StaticOrder, true, true>(F.lds, g, S, E); }
#endif
        SEAM(pb + 2);
        if (IN(pb + 3)) adaln_phase_h(F, Hs, ng + D, modl, 1, HN);
        SEAM(pb + 3);
#if G_WIN
        if (IN(pb + 4)) { pg8::Gemm g{HN, (const bf16*)(ws + WS_WIN + (size_t)l * WIN_ONE), M, NZ, D}; pg8::StaticOrder S; S.init(M, NZ, F.G, (int)blockIdx.x);
            pg8::EpiStoreBf16 E{Z, NZ}; pg8::gemm_phase<pg8::EpiStoreBf16, pg8::StaticOrder, true, true>(F.lds, g, S, E); if (REPK == 4) { __syncthreads(); pg8::gemm_phase<pg8::EpiStoreBf16, pg8::StaticOrder, true, true>(F.lds, g, S, E); } }
#endif
        SEAM(pb + 4);
        if (IN(pb + 5)) {
#if PH_PREP
            prep_phase(F, Z, KIN(I_MU) + (size_t)l * 3520, KIN(I_CKVG) + (size_t)l * 256, LA, CKV); if (REPK == 5) { __syncthreads(); prep_phase(F, Z, KIN(I_MU) + (size_t)l * 3520, KIN(I_CKVG) + (size_t)l * 256, LA, CKV); }
#endif
#if PH_TOPK
            topk_phase<((REPK == 61 || REPK == 63 || REPK == 64 || REPK == 65 || REPK == 66) ? 2 : 1), (REPK == 62 ? 2 : 1)>(F, Z, IDX);
            if (REPK == 6) { __syncthreads(); topk_phase<1, 1>(F, Z, IDX); }
#endif
        }
        SEAM(pb + 5);
        if (IN(pb + 6)) {
#if G_LORA
            { pg8::StaticOrder S; S.init(M, 1024, F.G, (int)blockIdx.x);
              pg8::Gemm g{LA + (size_t)2 * M * 256, (const bf16*)(ws + WS_WLORA + (size_t)(3 * l + 2) * WLORA_ONE), M, 1024, 256};
              pg8::EpiLora<2> E{nullptr, nullptr, nullptr, Gb, nullptr, nullptr, nullptr}; pg8::gemm_phase<pg8::EpiLora<2>, pg8::StaticOrder, true, true>(F.lds, g, S, E); }
            __syncthreads();
#endif
#if PH_SCAN
            chunk_phase<(REPK == 81 ? 2 : 1)>(F, Z, LA, (const bf16*)(ws + WS_WLORA + (size_t)(3 * l) * WLORA_ONE), KIN(I_W0) + (size_t)l * 1024, KIN(I_A0) + (size_t)l * 1024, KIN(I_MU) + (size_t)l * 3520, KIN(I_KK) + (size_t)l * 1024, KIN(I_KA) + (size_t)l * 1024, KIN(I_RK) + (size_t)l * 1024, RHOb, ZLOC, PT, QT, BONb);
#endif
        }
        SEAM(pb + 6);
        if (IN(pb + 8)) {
            attn_setup(F, KIN(I_T5));
#if PH_CHAIN
            chain_phase(F, PT, QT, SBb);
#endif
#if PH_ATTN
            attn_phase(F, Z, CKV, IDX, KIN(I_T5), O, (unsigned*)(F.ctl + CW_WQ + 512 * l));
            if (REPK == 7) attn_phase(F, Z, CKV, IDX, KIN(I_T5), O, (unsigned*)(F.ctl + CW_WQ + 4096 + 512 * l));
#endif
        }
        SEAM(pb + 8);
#if PH_ROUT
        if (IN(pb + 9)) { rwkv_out_phase(F, SBb, RHOb, ZLOC, Z, BONb, Gb, KIN(I_MU) + (size_t)l * 3520, KIN(I_LNW) + (size_t)l * 1024, KIN(I_LNB) + (size_t)l * 1024, O); if (REPK == 10) { __syncthreads(); rwkv_out_phase(F, SBb, RHOb, ZLOC, Z, BONb, Gb, KIN(I_MU) + (size_t)l * 3520, KIN(I_LNW) + (size_t)l * 1024, KIN(I_LNB) + (size_t)l * 1024, O); } }
#endif
        SEAM(pb + 9);
#if G_WOUT
        if (IN(pb + 10)) { pg8::Gemm g{O, (const bf16*)(ws + WS_WOUT + (size_t)l * WOUT_ONE), M, D, KO}; pg8::StaticOrder S; S.init(M, D, F.G, (int)blockIdx.x, 2);
            pg8::EpiResidH<false> E{Hs, Hs, D, modl + (3 + 2) * D, NMOD, RCOEF(1.0f)}; pg8::gemm_phase<pg8::EpiResidH<false>, pg8::StaticOrder, true, true>(F.lds, g, S, E); }
#endif
        SEAM(pb + 10);
        if (IN(pb + 11)) adaln_phase_h(F, Hs, ng + 2 * D, modl, 2, HN);
        SEAM(pb + 11);
#if G_FFI
        if (IN(pb + 12)) { pg8::Gemm g{HN, (const bf16*)(ws + WS_WFI + (size_t)(2 * l + 1) * WFI_ONE), M, NFI, D}; pg8::StaticOrder S; S.init(M, NFI, F.G, (int)blockIdx.x);
            pg8::EpiSwiglu E{ACT, FF}; pg8::gemm_phase<pg8::EpiSwiglu, pg8::StaticOrder, true, true>(F.lds, g, S, E); if (REPK == 1) { __syncthreads(); pg8::gemm_phase<pg8::EpiSwiglu, pg8::StaticOrder, true, true>(F.lds, g, S, E); } }
#endif
        SEAM(pb + 12);
#if G_FFO
        if (IN(pb + 13)) { pg8::Gemm g{ACT, (const bf16*)(ws + WS_WFO + (size_t)(2 * l + 1) * WFO_ONE), M, D, FF}; pg8::StaticOrder S; S.init(M, D, F.G, (int)blockIdx.x, 2);
            pg8::EpiResidH<false> E{Hs, Hs, D, modl + (6 + 2) * D, NMOD, RCOEF(0.5f)}; pg8::gemm_phase<pg8::EpiResidH<false>, pg8::StaticOrder, true, true>(F.lds, g, S, E); }
#endif
        SEAM(pb + 13);
    }

__global__ void __launch_bounds__(NTHR, 2) hybrid_fwd(Params P) {
    extern __shared__ __attribute__((aligned(16))) unsigned char lds_raw[];
    Frame F;
    F.lds = (LAS unsigned char*)lds_raw;
    F.MISC = (volatile LAS unsigned*)(F.lds + MISC_OFF);
    F.wave = __builtin_amdgcn_readfirstlane((int)threadIdx.x >> 6);
    F.G = gridDim.x; { const int bx = blockIdx.x; F.vcu = (F.G % 8 == 0) ? (bx % 8) * (F.G / 8) + bx / 8 : bx; }
    unsigned char* ws = kargs()->ws;
    F.ws = ws; F.ctl = (gu32*)(ws + WS_CTL);
    for (int u = ltid(); u < (LDS_BYTES - LDSCTL_OFF) / 4; u += NTHR) ((LAS unsigned*)(F.lds + LDSCTL_OFF))[u] = 0u;
    __syncthreads();
    const int lo = kargs()->ph_lo, hi = kargs()->ph_hi;
    XcdBarrier bar; bar.bar = (unsigned*)(F.ctl + CW_BAR); bar.x = 0; bar.st = nullptr;
    if (hi - lo > 1) bar = xcd_barrier_post((unsigned*)(F.ctl + CW_BAR), F.MISC + 8);
    float* const out = kargs()->out;

    if (IN(0)) { p0a_prologue(F); if (REPK == 20) { __syncthreads(); p0a_prologue(F); } } SEAM(0);
#if G_FOLD
    if (IN(1)) {
        for (int q = 0; q < 2 * DEPTH; ++q) {
            const int l = q >> 1, which = q & 1;
            const int c = (int)((blockIdx.x + F.G - 64 * q) % F.G);
            pg8::StaticOrder S; S.init(2048, 2048, F.G, c);
            const bf16* Ap = (const bf16*)(ws + (which ? WS_WOUTTA : WS_BDUK) + l * 4 * MiB); const bf16* Bp = (const bf16*)(ws + (which ? WS_BDUV : WS_WINQ) + l * 4 * MiB);
            bf16* Cp = which ? (bf16*)(ws + WS_WOUT + l * WOUT_ONE) : (bf16*)(ws + WS_WIN + l * WIN_ONE);
            pg8::Gemm g{Ap, Bp, 2048, 2048, 1024};
            pg8::EpiStoreBf16 E{Cp, which ? KO : D};
            pg8::gemm_phase<pg8::EpiStoreBf16, pg8::StaticOrder, true, true>(F.lds, g, S, E);
            if (REPK == 21) { __syncthreads(); pg8::gemm_phase<pg8::EpiStoreBf16, pg8::StaticOrder, true, true>(F.lds, g, S, E); }
        }
    }
#endif
    SEAM(1);
    layer_phases<0>(F, ws, out, lo, hi, bar);
    layer_phases<1>(F, ws, out, lo, hi, bar);
    if (IN(30)) final_norm_phase_h(F, Hs, out, KIN(I_FNG));
}

extern "C" void kernel_launch(void* const* d_in, const int* in_sizes, int n_in, void* d_out, int out_size, void* d_ws, size_t ws_size, hipStream_t stream) {
    static int grid = 0;
    if (grid == 0) {
        if (n_in != 25 || in_sizes[0] != M * D || out_size != M * D || ws_size < WS_END) { fprintf(stderr, "kernel_launch: unexpected problem (n_in %d, in0 %d, out %d, ws %zu < %zu)\n", n_in, n_in > 0 ? in_sizes[0] : -1, out_size, ws_size, (size_t)WS_END); grid = -1; return; }
        int dev = 0, cus = 0, per_cu = 0;
        if (hipGetDevice(&dev) != hipSuccess || hipDeviceGetAttribute(&cus, hipDeviceAttributeMultiprocessorCount, dev) != hipSuccess) { grid = -1; return; }
        if (hipFuncSetAttribute((const void*)hybrid_fwd, hipFuncAttributeMaxDynamicSharedMemorySize, LDS_BYTES) != hipSuccess) { fprintf(stderr, "kernel_launch: hipFuncSetAttribute failed\n"); grid = -1; return; }
        if (hipOccupancyMaxActiveBlocksPerMultiprocessor(&per_cu, (const void*)hybrid_fwd, NTHR, LDS_BYTES) != hipSuccess || per_cu < 1) { fprintf(stderr, "kernel_launch: occupancy query reports %d workgroups per CU\n", per_cu); }
        (void)hipGetLastError();
        grid = cus;
    }
    if (grid < 0) return;
    if (hipMemsetAsync((char*)d_ws + WS_CTL, 0, CTL_ZERO_BYTES, stream) != hipSuccess) return;
    Params p{};
    for (int i = 0; i < 25; ++i) p.in[i] = (const float*)d_in[i];
    p.out = (float*)d_out; p.ws = (unsigned char*)d_ws;
#if MK_ONE_LAUNCH
    p.ph_lo = 0; p.ph_hi = MK_LAST_PHASE;
    hipLaunchKernelGGL(hybrid_fwd, dim3(grid), dim3(NTHR), LDS_BYTES, stream, p);
#ifdef PROBE_LO
    if (hipMemsetAsync((char*)d_ws + WS_CTL, 0, CTL_ZERO_BYTES, stream) != hipSuccess) return;
    p.ph_lo = PROBE_LO; p.ph_hi = PROBE_HI; p.rerun = 1;
    hipLaunchKernelGGL(hybrid_fwd, dim3(grid), dim3(NTHR), LDS_BYTES, stream, p);
#endif
#else
    for (int ph = 0; ph < MK_LAST_PHASE; ++ph) { p.ph_lo = ph; p.ph_hi = ph + 1; hipLaunchKernelGGL(hybrid_fwd, dim3(grid), dim3(NTHR), LDS_BYTES, stream, p); }
#endif
}
```

```cpp
#include <hip/hip_runtime.h>
#include <cstdio>
#include <cstdint>

#ifndef REPK
#define REPK -1
#endif
constexpr int BATCH = 4, SEQ = 4096, D = 2048, DEPTH = 2, M = BATCH * SEQ;
constexpr int FF = 5632, NFI = 2 * FF;
constexpr int PIN = 5904;
constexpr int NZ = 7168;
constexpr int ZC_QLAT = 0, ZC_CKV = 2048, ZC_QIDX = 2304, ZC_KIDX = 3328, ZC_WIDX = 3392, ZC_WL = 3408, ZC_AL = 3504, ZC_GL = 3600, ZC_R = 4096, ZC_K = 5120, ZC_V = 6144;
constexpr int KO = 3072;
constexpr int TOPK = 256;
constexpr int NMOD = 9 * D;
constexpr float RMS_EPS = 1e-6f, GN_EPS = 64e-5f;
constexpr int CH = 64, NCH = SEQ / CH;

constexpr size_t MiB = 1u << 20;
constexpr size_t WS_CTL = 0, CTL_ZERO_BYTES = 1 * MiB;
constexpr size_t WS_MOD = 1 * MiB;
constexpr size_t WS_WFI = 2 * MiB, WFI_ONE = (size_t)NFI * D * 2;
constexpr size_t WS_WFO = 178 * MiB, WFO_ONE = (size_t)D * FF * 2;
constexpr size_t WS_WIN = 266 * MiB, WIN_ONE = (size_t)NZ * D * 2;
constexpr size_t WS_WOUT = 322 * MiB, WOUT_ONE = (size_t)D * KO * 2;
constexpr size_t WS_WLORA = 346 * MiB, WLORA_ONE = (size_t)1024 * 256 * 2;
constexpr size_t WS_HN = 350 * MiB;
constexpr size_t WS_ACT = 414 * MiB;
constexpr size_t WS_Z = 590 * MiB;
constexpr size_t WS_IDX = 814 * MiB;
constexpr size_t WS_CKV = 822 * MiB;
constexpr size_t WS_R = 830 * MiB, WS_V = 894 * MiB, WS_KK = 958 * MiB, WS_K = 1022 * MiB, WS_BETA = 1086 * MiB, WS_DEC = 1150 * MiB;
constexpr size_t WS_O = 1214 * MiB;
constexpr size_t WS_END = 1310 * MiB;
constexpr size_t WS_WINQ = WS_ACT, WS_WOUTTA = WS_ACT + 8 * MiB, WS_BDUK = WS_ACT + 16 * MiB, WS_BDUV = WS_ACT + 24 * MiB;
constexpr size_t WS_LA = WS_ACT;
constexpr size_t WS_G = WS_ACT + 24 * MiB;
constexpr size_t WS_PT = WS_ACT + 56 * MiB;
constexpr size_t WS_ST = WS_ACT + 88 * MiB;
constexpr size_t WS_RHO = WS_R + 32 * MiB, WS_QT = WS_V + 32 * MiB, WS_ZLOC = WS_KK + 32 * MiB;

constexpr int CW_BAR = 4096;
constexpr int CW_WQ = 16384;

constexpr int SCR_BYTES = 143360;
constexpr int LDSCTL_OFF = SCR_BYTES, MISC_OFF = LDSCTL_OFF + 320;
constexpr int LDS_BYTES = 147456;
constexpr int NWAVES = 8, NTHR = NWAVES * 64;

#define GAS __attribute__((address_space(1)))
#define LAS __attribute__((address_space(3)))
#define CAS __attribute__((address_space(4)))
typedef unsigned short bf16;
typedef unsigned v4u __attribute__((ext_vector_type(4)));
typedef unsigned v2u __attribute__((ext_vector_type(2)));
typedef float f32x4 __attribute__((ext_vector_type(4)));
typedef float f32x2 __attribute__((ext_vector_type(2)));
typedef float f32x16 __attribute__((ext_vector_type(16)));
typedef short bf16x8 __attribute__((ext_vector_type(8)));
typedef short bf16x4 __attribute__((ext_vector_type(4)));
typedef GAS unsigned gu32;
#define RLX_AGENT __ATOMIC_RELAXED, __HIP_MEMORY_SCOPE_AGENT
#define LDS_WAIT() asm volatile("s_waitcnt lgkmcnt(0)" ::: "memory")
#define VM_WAIT() asm volatile("s_waitcnt vmcnt(0)" ::: "memory")
__device__ __forceinline__ unsigned f2bf(float f) { unsigned u = __builtin_bit_cast(unsigned, f); return (u + 0x7fffu + ((u >> 16) & 1u)) >> 16; }
typedef __bf16 hwbf2 __attribute__((ext_vector_type(2)));
__device__ __forceinline__ unsigned pk2(float lo, float hi) { const f32x2 v = {lo, hi}; return __builtin_bit_cast(unsigned, __builtin_convertvector(v, hwbf2)); }
__device__ __forceinline__ float bflo(unsigned w) { return __builtin_bit_cast(float, w << 16); }
__device__ __forceinline__ float bfhi(unsigned w) { return __builtin_bit_cast(float, w & 0xffff0000u); }
__device__ __forceinline__ float bf2f(bf16 b) { return __builtin_bit_cast(float, ((unsigned)b) << 16); }
__device__ __forceinline__ float wave_sum(float v) {
#pragma unroll
    for (int o = 1; o < 64; o <<= 1) v += __shfl_xor(v, o);
    return v;
}
__device__ __forceinline__ float fast_exp(float x) { return __builtin_amdgcn_exp2f(x * 1.44269504089f); }
__device__ __forceinline__ float fast_sigmoid(float x) { return __builtin_amdgcn_rcpf(1.0f + fast_exp(-x)); }

__device__ __forceinline__ int ltid() { int t = threadIdx.x; asm volatile("" : "+v"(t)); return t; }
namespace pg8 {
#define PG8_LAS __attribute__((address_space(3)))
typedef unsigned short bf16_t;
typedef short bf16x8 __attribute__((ext_vector_type(8)));
typedef float f32x4 __attribute__((ext_vector_type(4)));
typedef unsigned u32x4 __attribute__((ext_vector_type(4)));
constexpr int BM = 256, BK = 64, HALF = 128, HTB = HALF * BK * 2  , STAGE_BYTES = 8 * HTB, NXCD = 8, WGM = 8;

__host__ __device__ __forceinline__ int lds_byte(int r, int c) { const int st = (r >> 4) * 2 + (c >> 5), rr = r & 15, cc = c & 31, ob = rr * 64 + cc * 2; return st * 1024 + (ob ^ (((ob >> 9) & 1) << 5)); }
__host__ __device__ __forceinline__ void stage_rc(int b, int& R, int& C) { const int st = b / 1024, sb = b % 1024, swz = sb ^ (((sb >> 9) & 1) << 5); R = (st >> 1) * 16 + swz / 64; C = (st & 1) * 32 + (swz % 64) / 2; }
__host__ __device__ __forceinline__ int perm32(int rho) { const int n = rho >> 4, i = rho & 15; return 8 * (i >> 2) + 4 * n + (i & 3); }

struct Unit { int pm, pn; };
struct Gemm { const bf16_t* A; const bf16_t* Bt; int M, N, K; };

struct StaticOrder {
    int nM, nN, nwg, G, c, wgm;
    __host__ __device__ void init(int M, int N, int G_, int c_, int wgm_ = WGM) { nM = M / BM; nN = N / BM; nwg = nM * nN; G = G_; c = c_; wgm = wgm_; }
    __host__ __device__ bool next(int i, Unit& u) const {
        const long L = (long)i * G + c; if (L >= nwg) return false;
        int wgid = (int)L; { const int q = nwg / NXCD, r = nwg % NXCD, xcd = wgid % NXCD, off = wgid / NXCD; wgid = (xcd < r ? xcd * (q + 1) : r * (q + 1) + (xcd - r) * q) + off; }
        const int nig = wgm * nN, gid = wgid / nig, fm = gid * wgm, gsz = (nM - fm) < wgm ? (nM - fm) : wgm;
        u.pm = fm + ((wgid % nig) % gsz); u.pn = (wgid % nig) / gsz; return true;
    }
    __device__ __forceinline__ void a_ready(const Unit&) const {}
    __device__ __forceinline__ size_t a_off(const Unit&) const { return 0; }
    __device__ __forceinline__ void done(const Unit&) const {}
};

__device__ __forceinline__ unsigned cvt_pk_bf16(float lo, float hi) { unsigned r; asm volatile("v_cvt_pk_bf16_f32 %0, %1, %2" : "=v"(r) : "v"(lo), "v"(hi)); return r; }
__device__ __forceinline__ unsigned cvt_pk_bf16_safe(float lo, float hi) { unsigned r; asm volatile("s_nop 1\n\tv_cvt_pk_bf16_f32 %0, %1, %2" : "=v"(r) : "v"(lo), "v"(hi)); return r; }
typedef float f32x2 __attribute__((ext_vector_type(2)));

struct EpiStoreBf16 {
    static constexpr bool PERM = true, AFTER_DRAIN = false;
    bf16_t* O; int ldc;
    __device__ __forceinline__ void operator()(const f32x4 (&acc)[2][2][4][2], const Unit& u, int wr, int wc, int fr, int fq) const {
        const int row0 = u.pm * BM + wr * 64 + fr, col0 = u.pn * BM + wc * 32 + 8 * fq;
#pragma unroll
        for (int ai = 0; ai < 2; ++ai)
#pragma unroll
            for (int m = 0; m < 4; ++m) { bf16_t* rowp = O + (size_t)(row0 + ai * HALF + m * 16) * ldc + col0;
#pragma unroll
                for (int bj = 0; bj < 2; ++bj) { const f32x4 v0 = acc[ai][bj][m][0], v1 = acc[ai][bj][m][1];
                    u32x4 w; w.x = cvt_pk_bf16(v0[0], v0[1]); w.y = cvt_pk_bf16(v0[2], v0[3]); w.z = cvt_pk_bf16(v1[0], v1[1]); w.w = cvt_pk_bf16(v1[2], v1[3]);
                    *(u32x4*)(rowp + bj * HALF) = w; } }
    }
};
struct EpiSwiglu {
    static constexpr bool PERM = true, AFTER_DRAIN = false;
    bf16_t* O; int ldc;
    __device__ __forceinline__ void operator()(const f32x4 (&acc)[2][2][4][2], const Unit& u, int wr, int wc, int fr, int fq) const {
        const int row0 = u.pm * BM + wr * 64 + fr, col0 = u.pn * HALF + wc * 32 + 8 * fq;
#pragma unroll
        for (int ai = 0; ai < 2; ++ai)
#pragma unroll
            for (int m = 0; m < 4; ++m) { bf16_t* rowp = O + (size_t)(row0 + ai * HALF + m * 16) * ldc + col0;
                f32x2 h[4];
#pragma unroll
                for (int n = 0; n < 2; ++n) { const f32x4 g = acc[ai][0][m][n], up = acc[ai][1][m][n];
#pragma unroll
                    for (int j = 0; j < 2; ++j) { const f32x2 g2 = {g[2 * j], g[2 * j + 1]}, u2 = {up[2 * j], up[2 * j + 1]};
                        const f32x2 t = g2 * -1.44269504089f; f32x2 d; d.x = __builtin_amdgcn_exp2f(t.x); d.y = __builtin_amdgcn_exp2f(t.y); d = d + 1.0f;
                        f32x2 r; r.x = __builtin_amdgcn_rcpf(d.x); r.y = __builtin_amdgcn_rcpf(d.y);
                        h[2 * n + j] = (g2 * u2) * r; } }
                u32x4 w; w.x = cvt_pk_bf16(h[0].x, h[0].y); w.y = cvt_pk_bf16(h[1].x, h[1].y); w.z = cvt_pk_bf16(h[2].x, h[2].y); w.w = cvt_pk_bf16(h[3].x, h[3].y);
                *(u32x4*)rowp = w; }
    }
};
struct EpiResid {
    static constexpr bool PERM = false, AFTER_DRAIN = false;
    const float* base; float* out; int ldc; const float* gate; int gate_bstride; float coef;
    __device__ __forceinline__ void operator()(const f32x4 (&acc)[2][2][4][2], const Unit& u, int wr, int wc, int fr, int fq) const {
        const int row0 = u.pm * BM + wr * 64 + fr, col0 = u.pn * BM + wc * 32 + 4 * fq;
        const float* gp = gate + (size_t)((u.pm * BM) >> 12) * gate_bstride + col0;
        f32x4 gv[2][2];
#pragma unroll
        for (int bj = 0; bj < 2; ++bj)
#pragma unroll
            for (int n = 0; n < 2; ++n) gv[bj][n] = *(const f32x4*)(gp + bj * HALF + n * 16) * coef;
        const float* bp = base + (size_t)row0 * ldc + col0; float* op = out + (size_t)row0 * ldc + col0;
        f32x4 b0[4][2][2], b1[4][2][2];
#pragma unroll
        for (int m = 0; m < 4; ++m)
#pragma unroll
            for (int bj = 0; bj < 2; ++bj)
#pragma unroll
                for (int n = 0; n < 2; ++n) b0[m][bj][n] = *(const f32x4*)(bp + (size_t)(m * 16) * ldc + bj * HALF + n * 16);
#pragma unroll
        for (int m = 0; m < 4; ++m)
#pragma unroll
            for (int bj = 0; bj < 2; ++bj)
#pragma unroll
                for (int n = 0; n < 2; ++n) b0[m][bj][n] += gv[bj][n] * acc[0][bj][m][n];
#pragma unroll
        for (int m = 0; m < 4; ++m)
#pragma unroll
            for (int bj = 0; bj < 2; ++bj)
#pragma unroll
                for (int n = 0; n < 2; ++n) b1[m][bj][n] = *(const f32x4*)(bp + (size_t)(HALF + m * 16) * ldc + bj * HALF + n * 16);
#pragma unroll
        for (int m = 0; m < 4; ++m)
#pragma unroll
            for (int bj = 0; bj < 2; ++bj)
#pragma unroll
                for (int n = 0; n < 2; ++n) *(f32x4*)(op + (size_t)(m * 16) * ldc + bj * HALF + n * 16) = b0[m][bj][n];
#pragma unroll
        for (int m = 0; m < 4; ++m)
#pragma unroll
            for (int bj = 0; bj < 2; ++bj)
#pragma unroll
                for (int n = 0; n < 2; ++n) *(f32x4*)(op + (size_t)(HALF + m * 16) * ldc + bj * HALF + n * 16) = b1[m][bj][n] + gv[bj][n] * acc[1][bj][m][n];
    }
};
template <bool BASE32> struct EpiResidH {
    static constexpr bool PERM = true, AFTER_DRAIN = false;
    const void* base; bf16_t* out; int ldc; const float* gate; int gate_bstride; float coef;
    __device__ __forceinline__ void operator()(const f32x4 (&acc)[2][2][4][2], const Unit& u, int wr, int wc, int fr, int fq) const {
        const int row0 = u.pm * BM + wr * 64 + fr, col0 = u.pn * BM + wc * 32 + 8 * fq;
        const float* gp = gate + (size_t)((u.pm * BM) >> 12) * gate_bstride + col0;
        f32x4 gv[2][2];
#pragma unroll
        for (int bj = 0; bj < 2; ++bj)
#pragma unroll
            for (int n = 0; n < 2; ++n) gv[bj][n] = *(const f32x4*)(gp + bj * HALF + 4 * n) * coef;
        bf16_t* op = out + (size_t)row0 * ldc + col0;
        if constexpr (!BASE32) {
            const bf16_t* bp = (const bf16_t*)base + (size_t)row0 * ldc + col0;
            u32x4 bb[2][4][2];
#pragma unroll
            for (int ai = 0; ai < 2; ++ai)
#pragma unroll
                for (int m = 0; m < 4; ++m)
#pragma unroll
                    for (int bj = 0; bj < 2; ++bj) bb[ai][m][bj] = *(const u32x4*)(bp + (size_t)(ai * HALF + m * 16) * ldc + bj * HALF);
#pragma unroll
            for (int ai = 0; ai < 2; ++ai)
#pragma unroll
                for (int m = 0; m < 4; ++m)
#pragma unroll
                    for (int bj = 0; bj < 2; ++bj) { const u32x4 b = bb[ai][m][bj]; const f32x4 a0 = acc[ai][bj][m][0] * gv[bj][0], a1 = acc[ai][bj][m][1] * gv[bj][1];
                        u32x4 w; w.x = cvt_pk_bf16(bflo(b.x) + a0[0], bfhi(b.x) + a0[1]); w.y = cvt_pk_bf16(bflo(b.y) + a0[2], bfhi(b.y) + a0[3]);
                        w.z = cvt_pk_bf16(bflo(b.z) + a1[0], bfhi(b.z) + a1[1]); w.w = cvt_pk_bf16(bflo(b.w) + a1[2], bfhi(b.w) + a1[3]);
                        *(u32x4*)(op + (size_t)(ai * HALF + m * 16) * ldc + bj * HALF) = w; }
        } else {
            const float* bp = (const float*)base + (size_t)row0 * ldc + col0;
#pragma unroll
            for (int ai = 0; ai < 2; ++ai) {
                f32x4 bf[4][2][2];
#pragma unroll
                for (int m = 0; m < 4; ++m)
#pragma unroll
                    for (int bj = 0; bj < 2; ++bj)
#pragma unroll
                        for (int n = 0; n < 2; ++n) bf[m][bj][n] = *(const f32x4*)(bp + (size_t)(ai * HALF + m * 16) * ldc + bj * HALF + 4 * n);
#pragma unroll
                for (int m = 0; m < 4; ++m)
#pragma unroll
                    for (int bj = 0; bj < 2; ++bj) { const f32x4 a0 = bf[m][bj][0] + acc[ai][bj][m][0] * gv[bj][0], a1 = bf[m][bj][1] + acc[ai][bj][m][1] * gv[bj][1];
                        u32x4 w; w.x = cvt_pk_bf16(a0[0], a0[1]); w.y = cvt_pk_bf16(a0[2], a0[3]); w.z = cvt_pk_bf16(a1[0], a1[1]); w.w = cvt_pk_bf16(a1[2], a1[3]);
                        *(u32x4*)(op + (size_t)(ai * HALF + m * 16) * ldc + bj * HALF) = w; }
            }
        }
    }
};
template <int MODE> struct EpiLora {
    static constexpr bool PERM = (MODE == 2), AFTER_DRAIN = false;
    float* o0; bf16_t* o0h; bf16_t* o1h; bf16_t* o2; const bf16_t* auxh; const float* v0; const float* v1;
    __device__ __forceinline__ void operator()(const f32x4 (&acc)[2][2][4][2], const Unit& u, int wr, int wc, int fr, int fq) const {
        const int row0 = u.pm * BM + wr * 64 + fr;
        if constexpr (MODE == 2) {
            const int col0 = u.pn * BM + wc * 32 + 8 * fq;
#pragma unroll
            for (int ai = 0; ai < 2; ++ai)
#pragma unroll
                for (int m = 0; m < 4; ++m) { bf16_t* rowp = o2 + (size_t)(row0 + ai * HALF + m * 16) * 1024 + col0;
#pragma unroll
                    for (int bj = 0; bj < 2; ++bj) { const f32x4 a0 = acc[ai][bj][m][0], a1 = acc[ai][bj][m][1];
                        u32x4 w; w.x = cvt_pk_bf16(a0[0], a0[1]); w.y = cvt_pk_bf16(a0[2], a0[3]); w.z = cvt_pk_bf16(a1[0], a1[1]); w.w = cvt_pk_bf16(a1[2], a1[3]);
                        *(u32x4*)(rowp + bj * HALF) = w; } }
        } else {
            const int col0 = u.pn * BM + wc * 32 + 4 * fq;
#pragma unroll
            for (int bj = 0; bj < 2; ++bj)
#pragma unroll
                for (int n = 0; n < 2; ++n) {
                    const int cc = col0 + bj * HALF + n * 16;
                    const f32x4 c0 = *(const f32x4*)(v0 + cc);
#pragma unroll
                    for (int ai = 0; ai < 2; ++ai)
#pragma unroll
                        for (int m = 0; m < 4; ++m) { const size_t o = (size_t)(row0 + ai * HALF + m * 16) * 1024 + cc; const f32x4 x = acc[ai][bj][m][n] + c0;
                            if constexpr (MODE == 0) { f32x4 r;
#pragma unroll
                                for (int j = 0; j < 4; ++j) { const float nx = -x[j];
                                    const float sp = fmaxf(nx, 0.f) + 0.69314718056f * __builtin_amdgcn_logf(1.0f + __builtin_amdgcn_exp2f(-1.44269504089f * fabsf(nx)));
                                    r[j] = __builtin_amdgcn_exp2f(-1.44269504089f * __builtin_amdgcn_exp2f(-1.44269504089f * (sp + 0.5f))); }
                                *(f32x4*)(o0 + o) = r; }
                            else { typedef unsigned u32x2 __attribute__((ext_vector_type(2))); float a[4];
#pragma unroll
                                for (int j = 0; j < 4; ++j) a[j] = __builtin_amdgcn_rcpf(1.0f + __builtin_amdgcn_exp2f(-1.44269504089f * x[j]));
                                u32x2 ao; ao.x = cvt_pk_bf16_safe(a[0], a[1]); ao.y = cvt_pk_bf16_safe(a[2], a[3]); *(u32x2*)(o1h + o) = ao; }
                            asm volatile("" ::: "memory"); }
                }
        }
    }
};

struct LoraOrder : StaticOrder {
    size_t a_stride;
    __device__ __forceinline__ size_t a_off(const Unit& u) const { return (size_t)(u.pn >> 2) * a_stride; }
};
struct EpiLoraAll {
    static constexpr bool PERM = false, AFTER_DRAIN = false;
    float* dec; bf16_t* kh; bf16_t* betah; bf16_t* gh; const bf16_t* kkh; const float* w0; const float* a0; const float* ka;
    __device__ __forceinline__ void operator()(const f32x4 (&acc)[2][2][4][2], const Unit& u, int wr, int wc, int fr, int fq) const {
        typedef unsigned u32x2 __attribute__((ext_vector_type(2)));
        const int mode = u.pn >> 2, row0 = u.pm * BM + wr * 64 + fr, col0 = (u.pn & 3) * BM + wc * 32 + 4 * fq;
#pragma unroll
        for (int bj = 0; bj < 2; ++bj)
#pragma unroll
            for (int n = 0; n < 2; ++n) {
                const int cc = col0 + bj * HALF + n * 16;
                f32x4 c0 = {0.f, 0.f, 0.f, 0.f}, c1 = {0.f, 0.f, 0.f, 0.f};
                if (mode == 0) c0 = *(const f32x4*)(w0 + cc); else if (mode == 1) { c0 = *(const f32x4*)(a0 + cc); c1 = *(const f32x4*)(ka + cc); }
#pragma unroll
                for (int ai = 0; ai < 2; ++ai)
#pragma unroll
                    for (int m = 0; m < 4; ++m) { const size_t o = (size_t)(row0 + ai * HALF + m * 16) * 1024 + cc; const f32x4 x = acc[ai][bj][m][n] + c0;
                        if (mode == 0) { f32x4 r;
#pragma unroll
                            for (int j = 0; j < 4; ++j) { const float nx = -x[j];
                                const float sp = fmaxf(nx, 0.f) + 0.69314718056f * __builtin_amdgcn_logf(1.0f + __builtin_amdgcn_exp2f(-1.44269504089f * fabsf(nx)));
                                r[j] = __builtin_amdgcn_exp2f(-1.44269504089f * __builtin_amdgcn_exp2f(-1.44269504089f * (sp + 0.5f))); }
                            *(f32x4*)(dec + o) = r; }
                        else if (mode == 1) {
                            const u32x2 kw = *(const u32x2*)(kh + o), kkw = *(const u32x2*)(kkh + o);
                            const float kv[4] = {__builtin_bit_cast(float, kw.x << 16), __builtin_bit_cast(float, kw.x & 0xffff0000u), __builtin_bit_cast(float, kw.y << 16), __builtin_bit_cast(float, kw.y & 0xffff0000u)};
                            const float kkv[4] = {__builtin_bit_cast(float, kkw.x << 16), __builtin_bit_cast(float, kkw.x & 0xffff0000u), __builtin_bit_cast(float, kkw.y << 16), __builtin_bit_cast(float, kkw.y & 0xffff0000u)};
                            float kn[4], bt[4];
#pragma unroll
                            for (int j = 0; j < 4; ++j) { const float a = __builtin_amdgcn_rcpf(1.0f + __builtin_amdgcn_exp2f(-1.44269504089f * x[j])); kn[j] = kv[j] * (1.0f + (a - 1.0f) * c1[j]); bt[j] = kkv[j] * a; }
                            u32x2 ko, bo; ko.x = cvt_pk_bf16(kn[0], kn[1]); ko.y = cvt_pk_bf16(kn[2], kn[3]); bo.x = cvt_pk_bf16(bt[0], bt[1]); bo.y = cvt_pk_bf16(bt[2], bt[3]);
                            *(u32x2*)(kh + o) = ko; *(u32x2*)(betah + o) = bo; }
                        else { u32x2 go; go.x = cvt_pk_bf16(x[0], x[1]); go.y = cvt_pk_bf16(x[2], x[3]); *(u32x2*)(gh + o) = go; }
                        asm volatile("" ::: "memory"); }
            }
    }
};
template <class Epi, class Sched, bool ALIGN_EPI = false, bool SP2 = false>
__device__ __forceinline__ void gemm_phase(PG8_LAS unsigned char* lds, const Gemm g, const Sched& S, const Epi& E) {
    int tid_l = threadIdx.x; asm volatile("" : "+v"(tid_l));
    const int tid = tid_l, wid = __builtin_amdgcn_readfirstlane(tid >> 6), lane = tid & 63, wr = wid >> 2, wc = wid & 3, fr = lane & 15, fq = lane >> 4;
    const int K = g.K, nt = K / BK;
    unsigned voffA[2], voffB[2];
#pragma unroll
    for (int i = 0; i < 2; ++i) { int R, C; stage_rc(tid * 16 + i * 8192, R, C); const int Rb = Epi::PERM ? ((R & ~31) + perm32(R & 31)) : R;
        voffA[i] = (unsigned)(R * K + C) * 2u; voffB[i] = (unsigned)(Rb * K + C) * 2u; }
    const size_t kstep = (size_t)(BK * 2);
    const size_t hstep = (size_t)HALF * K * 2;
    const size_t tstep = 2 * hstep;
    const unsigned ldsw = (unsigned)wid * 1024u;
    const int aoff = lds_byte(wr * 64 + fr, fq * 8), boff = lds_byte(wc * 32 + fr, fq * 8);
#define PG8_SA(b, h) (((b) * 2 + (h)) * HTB)
#define PG8_SB(b, h) ((4 + (b) * 2 + (h)) * HTB)
#define PG8_STAGE(bufoff, gbase, voff) do { _Pragma("unroll") for (int _i = 0; _i < 2; ++_i) \
        __builtin_amdgcn_global_load_lds((const unsigned*)((const char*)(gbase) + (voff)[_i]), (PG8_LAS unsigned*)(lds + (bufoff) + ldsw + _i * 8192), 16, 0, 0); } while (0)
#define PG8_LDA(dst, b, h) do { _Pragma("unroll") for (int m = 0; m < 4; ++m) _Pragma("unroll") for (int k = 0; k < 2; ++k) dst[m][k] = *(const PG8_LAS bf16x8*)(lds + PG8_SA(b, h) + aoff + m * 2048 + k * 1024); } while (0)
#define PG8_LDB(dst, b, h) do { _Pragma("unroll") for (int n = 0; n < 2; ++n) _Pragma("unroll") for (int k = 0; k < 2; ++k) dst[n][k] = *(const PG8_LAS bf16x8*)(lds + PG8_SB(b, h) + boff + n * 2048 + k * 1024); } while (0)
#define PG8_MMA(ai, bj, At, Bt) do { __builtin_amdgcn_s_setprio(1); _Pragma("unroll") for (int m = 0; m < 4; ++m) _Pragma("unroll") for (int n = 0; n < 2; ++n) _Pragma("unroll") for (int k = 0; k < 2; ++k) \
        acc[ai][bj][m][n] = __builtin_amdgcn_mfma_f32_16x16x32_bf16(Bt[n][k], At[m][k], acc[ai][bj][m][n], 0, 0, 0); __builtin_amdgcn_s_setprio(0); } while (0)
#define PG8_WAIT_V(n) asm volatile("s_waitcnt vmcnt(" #n ")" ::: "memory")
#define PG8_WAIT_L(n) asm volatile("s_waitcnt lgkmcnt(" #n ")" ::: "memory")
#define PG8_BAR __builtin_amdgcn_s_barrier()
#define PG8_SCHED __builtin_amdgcn_sched_barrier(0)
    Unit cur, nxt; int ui = 0;
    if (!S.next(0, cur)) return;
    f32x4 acc[2][2][4][2];
#pragma unroll
    for (int a = 0; a < 2; ++a)
#pragma unroll
        for (int b = 0; b < 2; ++b)
#pragma unroll
            for (int m = 0; m < 4; ++m)
#pragma unroll
                for (int n = 0; n < 2; ++n) acc[a][b][m][n] = (f32x4){0.f, 0.f, 0.f, 0.f};
    bf16x8 At[4][2], B0[2][2], B1[2][2];
    const char* cA = (const char*)g.A + S.a_off(cur) + (size_t)cur.pm * tstep; const char* cB = (const char*)g.Bt + (size_t)cur.pn * tstep;
    S.a_ready(cur);
    if constexpr (SP2) {
        PG8_STAGE(PG8_SB(0, 0), cB, voffB); PG8_STAGE(PG8_SB(0, 1), cB + hstep, voffB); PG8_STAGE(PG8_SA(0, 0), cA, voffA); PG8_STAGE(PG8_SA(0, 1), cA + hstep, voffA);
        if (wr == 1) PG8_BAR;
        PG8_WAIT_V(2); PG8_BAR;
        PG8_STAGE(PG8_SB(1, 0), cB + kstep, voffB); PG8_STAGE(PG8_SA(1, 0), cA + kstep, voffA); PG8_STAGE(PG8_SB(1, 1), cB + hstep + kstep, voffB);
        PG8_WAIT_V(6); PG8_BAR;
    } else {
        PG8_STAGE(PG8_SB(0, 0), cB, voffB); PG8_STAGE(PG8_SA(0, 0), cA, voffA); PG8_STAGE(PG8_SB(0, 1), cB + hstep, voffB); PG8_STAGE(PG8_SA(0, 1), cA + hstep, voffA);
        if (wr == 1) PG8_BAR;
        PG8_WAIT_V(4); PG8_BAR;
        PG8_STAGE(PG8_SB(1, 0), cB + kstep, voffB); PG8_STAGE(PG8_SA(1, 0), cA + kstep, voffA); PG8_STAGE(PG8_SB(1, 1), cB + hstep + kstep, voffB);
        PG8_WAIT_V(6); PG8_BAR;
    }
    for (;;) {
        const bool has_next = S.next(ui + 1, nxt);
        const char* nA = has_next ? (const char*)g.A + S.a_off(nxt) + (size_t)nxt.pm * tstep : cA; const char* nB = has_next ? (const char*)g.Bt + (size_t)nxt.pn * tstep : cB;
        for (int t = 0; t < nt; t += 2) {
            const bool last = (t == nt - 2);
            const char* a1 = cA + (size_t)(t + 1) * kstep;
            const char* a2 = last ? nA : cA + (size_t)(t + 2) * kstep; const char* b2 = last ? nB : cB + (size_t)(t + 2) * kstep;
            const char* a3 = a2 + kstep; const char* b3 = b2 + kstep;
            if (last && has_next) S.a_ready(nxt);
            if constexpr (SP2) {
            PG8_LDB(B0, 0, 0); PG8_LDB(B1, 0, 1); PG8_SCHED; PG8_LDA(At, 0, 0); PG8_STAGE(PG8_SA(1, 1), a1 + hstep, voffA);
            PG8_WAIT_V(8); PG8_WAIT_L(0); PG8_BAR; PG8_MMA(0, 0, At, B0); PG8_MMA(0, 1, At, B1); PG8_BAR; PG8_SCHED;
            PG8_LDA(At, 0, 1); PG8_STAGE(PG8_SB(0, 0), b2, voffB); PG8_STAGE(PG8_SB(0, 1), b2 + hstep, voffB); PG8_STAGE(PG8_SA(0, 0), a2, voffA);
            PG8_WAIT_V(8); PG8_WAIT_L(0); PG8_BAR; PG8_MMA(1, 0, At, B0); PG8_MMA(1, 1, At, B1); PG8_BAR; PG8_SCHED;
            PG8_LDB(B0, 1, 0); PG8_LDB(B1, 1, 1); PG8_SCHED; PG8_LDA(At, 1, 0); PG8_STAGE(PG8_SA(0, 1), a2 + hstep, voffA);
            PG8_WAIT_V(8); PG8_WAIT_L(0); PG8_BAR; PG8_MMA(0, 0, At, B0); PG8_MMA(0, 1, At, B1); PG8_BAR; PG8_SCHED;
            PG8_LDA(At, 1, 1); PG8_STAGE(PG8_SB(1, 0), b3, voffB); PG8_STAGE(PG8_SB(1, 1), b3 + hstep, voffB); PG8_STAGE(PG8_SA(1, 0), a3, voffA);
            PG8_WAIT_V(8); PG8_WAIT_L(0); PG8_BAR; PG8_MMA(1, 0, At, B0); PG8_MMA(1, 1, At, B1); PG8_BAR; PG8_SCHED;
            } else {
            PG8_LDB(B0, 0, 0); PG8_SCHED; PG8_LDA(At, 0, 0); PG8_STAGE(PG8_SA(1, 1), a1 + hstep, voffA);
            PG8_WAIT_L(8); PG8_BAR; PG8_WAIT_L(0); PG8_MMA(0, 0, At, B0); PG8_BAR; PG8_SCHED;
            PG8_LDB(B1, 0, 1); PG8_STAGE(PG8_SB(0, 0), b2, voffB);
            PG8_BAR; PG8_WAIT_L(0); PG8_MMA(0, 1, At, B1); PG8_BAR;
            PG8_LDA(At, 0, 1); PG8_STAGE(PG8_SA(0, 0), a2, voffA);
            PG8_BAR; PG8_WAIT_L(0); PG8_MMA(1, 0, At, B0); PG8_BAR; PG8_SCHED;
            PG8_STAGE(PG8_SB(0, 1), b2 + hstep, voffB);
            PG8_WAIT_V(6); PG8_BAR; PG8_MMA(1, 1, At, B1); PG8_BAR;
            PG8_LDB(B0, 1, 0); PG8_SCHED; PG8_LDA(At, 1, 0); PG8_STAGE(PG8_SA(0, 1), a2 + hstep, voffA);
            PG8_WAIT_L(8); PG8_BAR; PG8_WAIT_L(0); PG8_MMA(0, 0, At, B0); PG8_BAR; PG8_SCHED;
            PG8_LDB(B1, 1, 1); PG8_STAGE(PG8_SB(1, 0), b3, voffB);
            PG8_BAR; PG8_WAIT_L(0); PG8_MMA(0, 1, At, B1); PG8_BAR;
            PG8_LDA(At, 1, 1); PG8_STAGE(PG8_SA(1, 0), a3, voffA);
            PG8_BAR; PG8_WAIT_L(0); PG8_MMA(1, 0, At, B0); PG8_BAR; PG8_SCHED;
            PG8_STAGE(PG8_SB(1, 1), b3 + hstep, voffB);
            PG8_WAIT_V(6); PG8_BAR; PG8_MMA(1, 1, At, B1); PG8_BAR;
            }
        }
        if constexpr (ALIGN_EPI) { if (wr == 0) PG8_BAR; }
        if constexpr (!Epi::AFTER_DRAIN) { E(acc, cur, wr, wc, fr, fq); S.done(cur); }
        if (!has_next) break;
#pragma unroll
        for (int a = 0; a < 2; ++a)
#pragma unroll
            for (int b = 0; b < 2; ++b)
#pragma unroll
                for (int m = 0; m < 4; ++m)
#pragma unroll
                    for (int n = 0; n < 2; ++n) acc[a][b][m][n] = (f32x4){0.f, 0.f, 0.f, 0.f};
        cur = nxt; cA = nA; cB = nB; ++ui;
        if constexpr (ALIGN_EPI) { if (wr == 1) PG8_BAR; }
    }
    PG8_WAIT_V(0);
    if constexpr (!ALIGN_EPI) { if (wr == 0) PG8_BAR; }
    PG8_BAR;
    if constexpr (Epi::AFTER_DRAIN) { E.fused(acc, cur, wr, wc, fr, fq, lds, wid, lane); S.done(cur); }
#undef PG8_SA
#undef PG8_SB
#undef PG8_STAGE
#undef PG8_LDA
#undef PG8_LDB
#undef PG8_MMA
#undef PG8_WAIT_V
#undef PG8_WAIT_L
#undef PG8_BAR
#undef PG8_SCHED
}
}
#define XB_TMO      128
#define XB_XCNT(j)  (256  + 64 * (j))
#define XB_XSUB(j)  (1280 + 64 * (j))
#define XB_XGEN(j)  (2304 + 64 * (j))
#define XB_TOP      3328
#define XB_TOPGEN   3392
#define XCD_BAR_WORDS 3456
#define XB_SPIN_CAP (1u << 18)

__device__ __forceinline__ unsigned xb_ld(unsigned* p)              { return __hip_atomic_load(p, __ATOMIC_RELAXED, __HIP_MEMORY_SCOPE_AGENT); }
__device__ __forceinline__ unsigned xb_add(unsigned* p, unsigned v) { return __hip_atomic_fetch_add(p, v, __ATOMIC_RELAXED, __HIP_MEMORY_SCOPE_AGENT); }
__device__ __forceinline__ unsigned xb_xcc_id() { return (unsigned)__builtin_amdgcn_s_getreg((3 << 11) | 20) & 0xFu; }
#define XB_SPIN(cond, bar) do { unsigned _sp = 0; while (cond) { __builtin_amdgcn_s_sleep(1); \
    if ((++_sp & 255u) == 0u) { if (xb_ld(&(bar)[XB_TMO])) break; if (_sp > XB_SPIN_CAP) { atomicAdd(&(bar)[XB_TMO], 1u); break; } } } } while (0)

struct XcdBarrier {
    unsigned* bar; unsigned x;
    volatile LAS unsigned* st;
};

__device__ __forceinline__ XcdBarrier xcd_barrier_post(unsigned* bar, volatile LAS unsigned* st) {
    XcdBarrier b; b.bar = bar; b.x = xb_xcc_id(); b.st = st;
    if (threadIdx.x == 0) (void)xb_add(&bar[XB_XCNT(b.x)], 1u);
    return b;
}
__device__ __forceinline__ void xcd_barrier_complete(unsigned* bar, unsigned x, unsigned& nloc, unsigned& nx) {
    const unsigned G = gridDim.x * gridDim.y * gridDim.z;
    unsigned sum, cnt, mine, sp = 0u;
    for (;;) {
        sum = 0u; cnt = 0u; mine = 0u;
#pragma unroll
        for (unsigned j = 0; j < 16; ++j) { const unsigned c = xb_ld(&bar[XB_XCNT(j)]); sum += c; cnt += (c > 0u) ? 1u : 0u; mine = (j == x) ? c : mine; }
        if (sum == G) break;
        __builtin_amdgcn_s_sleep(1);
        if ((++sp & 255u) == 0u) { if (xb_ld(&bar[XB_TMO])) break; if (sp > XB_SPIN_CAP) { atomicAdd(&bar[XB_TMO], 1u); break; } }
    }
    nloc = mine > 0u ? mine : 1u; nx = cnt > 0u ? cnt : 1u;
}

__device__ __forceinline__ void xcd_barrier(const XcdBarrier& b) {
    asm volatile("s_waitcnt vmcnt(0)" ::: "memory");
    __syncthreads();
    if (threadIdx.x == 0) {
        unsigned* bar = b.bar;
        __builtin_amdgcn_s_waitcnt(0);
        unsigned nloc = b.st[0], nx = b.st[1];
        if (nloc == 0u) { xcd_barrier_complete(bar, b.x, nloc, nx); b.st[0] = nloc; b.st[1] = nx; }
        const unsigned old = xb_add(&bar[XB_XSUB(b.x)], 1u);
        const unsigned gen = old / nloc;
        if (old + 1u == (gen + 1u) * nloc) {
            __builtin_amdgcn_fence(__ATOMIC_RELEASE, "agent");
            asm volatile("s_waitcnt vmcnt(0)" ::: "memory");
            const unsigned og = xb_add(&bar[XB_TOP], 1u);
            const unsigned tg = og / nx;
            if (og + 1u == (tg + 1u) * nx) xb_add(&bar[XB_TOPGEN], 1u);
            else XB_SPIN(xb_ld(&bar[XB_TOPGEN]) == tg, bar);
            __builtin_amdgcn_fence(__ATOMIC_ACQUIRE, "agent");
            xb_add(&bar[XB_XGEN(b.x)], 1u);
            asm volatile("s_waitcnt vmcnt(0)" ::: "memory");
        } else {
            XB_SPIN(xb_ld(&bar[XB_XGEN(b.x)]) == gen, bar);
            __builtin_amdgcn_fence(__ATOMIC_ACQUIRE, "agent");
            asm volatile("s_waitcnt vmcnt(0)" ::: "memory");
        }
    }
    __syncthreads();
}

struct Frame {
    LAS unsigned char* lds;
    volatile LAS unsigned* MISC;
    gu32* ctl;
    int wave, vcu, G;
    unsigned char* ws;
};
#ifdef PROBE_LO
struct Params { const float* in[25]; float* out; unsigned char* ws; int ph_lo, ph_hi; int rerun, rsv; };
#define RCOEF(c) (kargs()->rerun ? 0.f : (c))
#else
struct Params { const float* in[25]; float* out; unsigned char* ws; int ph_lo, ph_hi; };
#define RCOEF(c) (c)
#endif
__device__ __forceinline__ const CAS Params* kargs() { const CAS Params* q = (const CAS Params*)__builtin_amdgcn_kernarg_segment_ptr(); asm volatile("" : "+s"(q)); return q; }
#define KIN(i) ((const float*)kargs()->in[i])
enum { I_X = 0, I_C, I_T5, I_ADAW, I_ADAB, I_NORMG, I_FWI, I_FWO, I_WIN, I_CKVG, I_WUK, I_WUV, I_MU, I_W0, I_W2, I_A0, I_A2, I_G2, I_KK, I_KA, I_RK, I_LNW, I_LNB, I_WOUT, I_FNG };

template <class Map>
__device__ __forceinline__ void conv_load(float (&v)[32], int it, int nblk, const float* src, int ld_src, int Ks, const Map& map, int lane_) {
    const int kb = it / nblk, nb = it % nblk; float sc = 1.f; const int scol = map(32 * nb + (lane_ & 31), sc);
    const unsigned loff = (unsigned)((lane_ >> 5) * ld_src + (scol < 0 ? 0 : scol));
#pragma unroll
    for (int i = 0; i < 32; ++i) { const int ku = 64 * kb + 2 * i; const int kc = ku < Ks ? ku : Ks - 2; v[i] = (src + (size_t)kc * ld_src)[loff]; }
}
template <class Map>
__device__ __forceinline__ void conv_proc(const float (&v)[32], int it, int nblk, int Ks, LAS float* scr, bf16* dst, int ldd, const Map& map, int lane_) {
    const int kb = it / nblk, nb = it % nblk, k0 = 64 * kb, n0 = 32 * nb; float sc = 1.f; const int scol = map(n0 + (lane_ & 31), sc); if (scol < 0) sc = 0.f;
#pragma unroll
    for (int i = 0; i < 32; ++i) scr[(2 * i + (lane_ >> 5)) * 33 + (lane_ & 31)] = v[i] * ((k0 + 2 * i < Ks) ? sc : 0.f);
    LDS_WAIT(); asm volatile("" ::: "memory");
    const int c = lane_ & 7;
#pragma unroll
    for (int j = 0; j < 4; ++j) { const int n = (lane_ >> 3) + 8 * j; const LAS float* s = scr + (8 * c) * 33 + n;
        v4u o; o.x = pk2(s[0 * 33], s[1 * 33]); o.y = pk2(s[2 * 33], s[3 * 33]); o.z = pk2(s[4 * 33], s[5 * 33]); o.w = pk2(s[6 * 33], s[7 * 33]);
        *(GAS v4u*)(dst + (size_t)(n0 + n) * ldd + k0 + 8 * c) = o; }
    LDS_WAIT(); asm volatile("" ::: "memory");
}
template <class Map>
__device__ __forceinline__ void convT(const Frame& F, const float* src, int ld_src, int Ks, int Kd, bf16* dst, int Nd, int ldd, const Map map, int& rot) {
    const int lane_ = ltid() & 63;
    LAS float* scr = (LAS float*)(F.lds + F.wave * 16384);
    const int NGW = F.G * NWAVES; int gw = F.vcu * NWAVES + F.wave - rot; if (gw < 0) gw += NGW;
    const int nblk = Nd / 32, nitems = (Kd / 64) * nblk;
    rot = (rot + nitems) % NGW;
    float va[32], vb[32];
    if (gw < nitems) conv_load(va, gw, nblk, src, ld_src, Ks, map, lane_);
    for (int it = gw; it < nitems; it += 2 * NGW) {
        const int i1 = it + NGW, i2 = i1 + NGW;
        if (i1 < nitems) conv_load(vb, i1, nblk, src, ld_src, Ks, map, lane_);
        conv_proc(va, it, nblk, Ks, scr, dst, ldd, map, lane_);
        if (i2 < nitems) conv_load(va, i2, nblk, src, ld_src, Ks, map, lane_);
        if (i1 < nitems) conv_proc(vb, i1, nblk, Ks, scr, dst, ldd, map, lane_);
    }
}
struct MapId { __device__ __forceinline__ int operator()(int n, float&) const { return n; } };
struct MapFfnIn { __device__ __forceinline__ int operator()(int n, float&) const { return ((n & 128) ? FF : 0) + (n >> 8) * 128 + (n & 127); } };
struct MapWin {
    __device__ __forceinline__ int operator()(int n, float& sc) const { const int zc = 2048 + n;
        if (zc < ZC_WL) { if (zc >= ZC_WIDX) sc = 0.03125f; return zc - 2048 + 1024; }
        if (zc < 3856) return 5456 + (zc - ZC_WL);
        if (zc < ZC_R) return -1;
        return 2384 + (zc - ZC_R); } };

__device__ __forceinline__ void p0a_prologue(Frame& F) {
    const int tid_ = ltid(), lane_ = tid_ & 63;
    const int gw = F.vcu * NWAVES + F.wave, NGW = F.G * NWAVES;
    const size_t gt = (size_t)gw * 64 + lane_, NGT = (size_t)NGW * 64;
    unsigned char* ws = F.ws;
    {
        LAS float* cact = (LAS float*)F.lds;
        LAS float* red = (LAS float*)(F.lds + 32768);
        for (int i = tid_; i < BATCH * D; i += NTHR) { const float cv = KIN(I_C)[i]; cact[i] = cv / (1.0f + __expf(-cv)); }
        __syncthreads();
        float* mod = (float*)(ws + WS_MOD);
        const int ntask = DEPTH * (NMOD / 128);
        for (int task = F.vcu; task < ntask; task += F.G) {
            const int l = task / (NMOD / 128), c0 = (task % (NMOD / 128)) * 128;
            const float* W = KIN(I_ADAW) + (size_t)l * D * NMOD + c0 + 4 * (lane_ & 31);
            f32x4 a[4] = {{0.f, 0.f, 0.f, 0.f}, {0.f, 0.f, 0.f, 0.f}, {0.f, 0.f, 0.f, 0.f}, {0.f, 0.f, 0.f, 0.f}};
            const int kbase = F.wave * 256 + (lane_ >> 5);
#pragma unroll 16
            for (int i = 0; i < 128; ++i) { const int k = kbase + 2 * i; const f32x4 w = *(const GAS f32x4*)(W + (size_t)k * NMOD);
#pragma unroll
                for (int b = 0; b < 4; ++b) a[b] += w * cact[b * D + k]; }
#pragma unroll
            for (int b = 0; b < 4; ++b) {
#pragma unroll
                for (int j = 0; j < 4; ++j) a[b][j] += __shfl_xor(a[b][j], 32);
                if (lane_ < 32) *(LAS f32x4*)(red + (F.wave * 4 + b) * 128 + 4 * lane_) = a[b]; }
            __syncthreads();
            { const int b = tid_ >> 7, c = tid_ & 127; float s = 0.f;
#pragma unroll
              for (int w = 0; w < 8; ++w) s += red[(w * 4 + b) * 128 + c];
              mod[((size_t)l * BATCH + b) * NMOD + c0 + c] = s + KIN(I_ADAB)[(size_t)l * NMOD + c0 + c]; }
            __syncthreads();
        }
        __syncthreads();
    }
    int rot = 0;
    for (int li = 0; li < 2 * DEPTH; ++li) {
        convT(F, KIN(I_FWI) + (size_t)li * D * NFI, NFI, D, D, (bf16*)(ws + WS_WFI + li * WFI_ONE), NFI, D, MapFfnIn(), rot);
        convT(F, KIN(I_FWO) + (size_t)li * FF * D, D, FF, FF, (bf16*)(ws + WS_WFO + li * WFO_ONE), D, FF, MapId(), rot);
    }
    for (int l = 0; l < DEPTH; ++l) {
        convT(F, KIN(I_WIN) + (size_t)l * D * PIN, PIN, D, D, (bf16*)(ws + WS_WIN + l * WIN_ONE) + (size_t)2048 * D, NZ - 2048, D, MapWin(), rot);
        convT(F, KIN(I_WOUT) + (size_t)l * D * D + (size_t)1024 * D, D, 1024, 1024, (bf16*)(ws + WS_WOUT + l * WOUT_ONE) + 2048, D, KO, MapId(), rot);
        convT(F, KIN(I_WOUT) + (size_t)l * D * D, D, 1024, 1024, (bf16*)(ws + WS_WOUTTA + l * 4 * MiB), D, 1024, MapId(), rot);
        convT(F, KIN(I_W2) + (size_t)l * 96 * 1024, 1024, 96, 256, (bf16*)(ws + WS_WLORA + (l * 3 + 0) * WLORA_ONE), 1024, 256, MapId(), rot);
        convT(F, KIN(I_A2) + (size_t)l * 96 * 1024, 1024, 96, 256, (bf16*)(ws + WS_WLORA + (l * 3 + 1) * WLORA_ONE), 1024, 256, MapId(), rot);
        convT(F, KIN(I_G2) + (size_t)l * 256 * 1024, 1024, 256, 256, (bf16*)(ws + WS_WLORA + (l * 3 + 2) * WLORA_ONE), 1024, 256, MapId(), rot);
        const float* win = KIN(I_WIN) + (size_t)l * D * PIN; bf16* winq = (bf16*)(ws + WS_WINQ + l * 4 * MiB);
        const float* wuk = KIN(I_WUK) + (size_t)l * 256 * 1024; const float* wuv = KIN(I_WUV) + (size_t)l * 256 * 1024;
        bf16* bduk = (bf16*)(ws + WS_BDUK + l * 4 * MiB); bf16* bduv = (bf16*)(ws + WS_BDUV + l * 4 * MiB);
        for (size_t e = gt; e < (size_t)2048 * 128; e += NGT) {
            const int row = (int)(e >> 7), c8 = (int)(e & 127) * 8;
            { const float* s = win + (size_t)row * PIN + c8; const f32x4 a = *(const GAS f32x4*)s, b = *(const GAS f32x4*)(s + 4);
              v4u o; o.x = pk2(a.x, a.y); o.y = pk2(a.z, a.w); o.z = pk2(b.x, b.y); o.w = pk2(b.z, b.w); *(GAS v4u*)(winq + (size_t)row * 1024 + c8) = o; }
            const int h = row >> 8, r = row & 255, hp = c8 >> 7;
            v4u ok = {0u, 0u, 0u, 0u}, ov = {0u, 0u, 0u, 0u};
            if (h == hp) { const float qs = 0.08838834764831845f;
                const float* s = wuk + (size_t)r * 1024 + c8; const f32x4 a = *(const GAS f32x4*)s * qs, b = *(const GAS f32x4*)(s + 4) * qs;
                ok.x = pk2(a.x, a.y); ok.y = pk2(a.z, a.w); ok.z = pk2(b.x, b.y); ok.w = pk2(b.z, b.w);
                const float* t = wuv + (size_t)r * 1024 + c8; const f32x4 c = *(const GAS f32x4*)t, d = *(const GAS f32x4*)(t + 4);
                ov.x = pk2(c.x, c.y); ov.y = pk2(c.z, c.w); ov.z = pk2(d.x, d.y); ov.w = pk2(d.z, d.w); }
            *(GAS v4u*)(bduk + (size_t)row * 1024 + c8) = ok; *(GAS v4u*)(bduv + (size_t)row * 1024 + c8) = ov;
        }
    }
}

__device__ __forceinline__ float row_sumsq(const f32x4 (&v)[8]) { float s = 0.f;
#pragma unroll
    for (int j = 0; j < 8; ++j) s += (v[j].x * v[j].x + v[j].y * v[j].y) + (v[j].z * v[j].z + v[j].w * v[j].w);
    return wave_sum(s); }
__device__ __forceinline__ void adaln_phase(const Frame& F, const float* h, const float* g, const float* modl  , int sub, bf16* hn) {
    const int lane_ = ltid() & 63;
    const int gw = F.vcu * NWAVES + F.wave, NGW = F.G * NWAVES;
    for (int grp = gw; grp < M / 8; grp += NGW) {
        const int m0 = grp * 8, b = m0 >> 12;
        const float* sh = modl + (size_t)b * NMOD + (sub * 3 + 0) * D; const float* scl = sh + D;
        f32x4 ga[8], sb[8];
#pragma unroll
        for (int j = 0; j < 8; ++j) { const int c = 4 * lane_ + 256 * j; ga[j] = *(const GAS f32x4*)(g + c) * (*(const GAS f32x4*)(scl + c) + 1.0f); sb[j] = *(const GAS f32x4*)(sh + c); }
        const GAS f32x4* xr = (const GAS f32x4*)(h + (size_t)m0 * D) + lane_; GAS v2u* o8 = (GAS v2u*)(hn + (size_t)m0 * D) + lane_;
        f32x4 va[8], vb[8];
#define AL_LOAD(v, r) { _Pragma("unroll") for (int j = 0; j < 8; ++j) v[j] = xr[(size_t)(r) * (D / 4) + 64 * j]; }
#define AL_PROC(v, r) { const float rstd = 1.0f / sqrtf(row_sumsq(v) * (1.0f / D) + RMS_EPS); \
            _Pragma("unroll") for (int j = 0; j < 8; ++j) { const f32x4 y = v[j] * rstd * ga[j] + sb[j]; v2u o; o.x = pk2(y.x, y.y); o.y = pk2(y.z, y.w); o8[(size_t)(r) * (D / 4) + 64 * j] = o; } }
        AL_LOAD(va, 0)
#pragma unroll 1
        for (int r = 0; r < 8; r += 2) { AL_LOAD(vb, r + 1) AL_PROC(va, r) if (r + 2 < 8) AL_LOAD(va, r + 2) AL_PROC(vb, r + 1) }
#undef AL_LOAD
#undef AL_PROC
    }
}

__device__ __forceinline__ void final_norm_phase(const Frame& F, float* out, const float* g) {
    const int lane_ = ltid() & 63;
    const int gw = F.vcu * NWAVES + F.wave, NGW = F.G * NWAVES;
    for (int grp = gw; grp < M / 8; grp += NGW) {
        f32x4 gg[8];
#pragma unroll
        for (int j = 0; j < 8; ++j) gg[j] = *(const GAS f32x4*)(g + 4 * lane_ + 256 * j);
        GAS f32x4* xr = (GAS f32x4*)(out + (size_t)grp * 8 * D) + lane_;
        f32x4 va[8], vb[8];
#define FN_LOAD(v, r) { _Pragma("unroll") for (int j = 0; j < 8; ++j) v[j] = xr[(size_t)(r) * (D / 4) + 64 * j]; }
#define FN_PROC(v, r) { const float rstd = 1.0f / sqrtf(row_sumsq(v) * (1.0f / D) + RMS_EPS); \
            _Pragma("unroll") for (int j = 0; j < 8; ++j) xr[(size_t)(r) * (D / 4) + 64 * j] = v[j] * rstd * gg[j]; }
        FN_LOAD(va, 0)
#pragma unroll 1
        for (int r = 0; r < 8; r += 2) { FN_LOAD(vb, r + 1) FN_PROC(va, r) if (r + 2 < 8) FN_LOAD(va, r + 2) FN_PROC(vb, r + 1) }
#undef FN_LOAD
#undef FN_PROC
    }
}

__device__ __forceinline__ float row_sumsq_h(const v4u (&v)[4]) { float s = 0.f;
#pragma unroll
    for (int j = 0; j < 4; ++j) { float x[8]; x[0] = bflo(v[j].x); x[1] = bfhi(v[j].x); x[2] = bflo(v[j].y); x[3] = bfhi(v[j].y); x[4] = bflo(v[j].z); x[5] = bfhi(v[j].z); x[6] = bflo(v[j].w); x[7] = bfhi(v[j].w);
        s += ((x[0] * x[0] + x[1] * x[1]) + (x[2] * x[2] + x[3] * x[3])) + ((x[4] * x[4] + x[5] * x[5]) + (x[6] * x[6] + x[7] * x[7])); }
    return wave_sum(s); }
__device__ __forceinline__ void adaln_phase_h(const Frame& F, const bf16* h, const float* g, const float* modl  , int sub, bf16* hn) {
    const int lane_ = ltid() & 63;
    const int gw = F.vcu * NWAVES + F.wave, NGW = F.G * NWAVES;
    for (int grp = gw; grp < M / 8; grp += NGW) {
        const int m0 = grp * 8, b = m0 >> 12;
        const float* sh = modl + (size_t)b * NMOD + (sub * 3 + 0) * D; const float* scl = sh + D;
        const GAS v4u* xr = (const GAS v4u*)(h + (size_t)m0 * D) + lane_; GAS v4u* o8 = (GAS v4u*)(hn + (size_t)m0 * D) + lane_;
        v4u va[4][4], vb[4][4];
#pragma unroll
        for (int r = 0; r < 4; ++r)
#pragma unroll
            for (int j = 0; j < 4; ++j) va[r][j] = xr[(size_t)r * (D / 8) + 64 * j];
#pragma unroll
        for (int r = 0; r < 4; ++r)
#pragma unroll
            for (int j = 0; j < 4; ++j) vb[r][j] = xr[(size_t)(r + 4) * (D / 8) + 64 * j];
        f32x4 ga[4][2], sb[4][2];
#pragma unroll
        for (int j = 0; j < 4; ++j)
#pragma unroll
            for (int n = 0; n < 2; ++n) { const int c = 8 * lane_ + 512 * j + 4 * n; ga[j][n] = *(const GAS f32x4*)(g + c) * (*(const GAS f32x4*)(scl + c) + 1.0f); sb[j][n] = *(const GAS f32x4*)(sh + c); }
#define ALH_PROC(v, r) { const float rstd = 1.0f / sqrtf(row_sumsq_h(v) * (1.0f / D) + RMS_EPS); \
            _Pragma("unroll") for (int j = 0; j < 4; ++j) { const v4u w = v[j]; \
                const f32x4 x0 = {bflo(w.x), bfhi(w.x), bflo(w.y), bfhi(w.y)}, x1 = {bflo(w.z), bfhi(w.z), bflo(w.w), bfhi(w.w)}; \
                const f32x4 y0 = x0 * rstd * ga[j][0] + sb[j][0], y1 = x1 * rstd * ga[j][1] + sb[j][1]; \
                v4u o; o.x = pk2(y0.x, y0.y); o.y = pk2(y0.z, y0.w); o.z = pk2(y1.x, y1.y); o.w = pk2(y1.z, y1.w); o8[(size_t)(r) * (D / 8) + 64 * j] = o; } }
#pragma unroll
        for (int r = 0; r < 4; ++r) ALH_PROC(va[r], r)
#pragma unroll
        for (int r = 0; r < 4; ++r) ALH_PROC(vb[r], r + 4)
#undef ALH_PROC
    }
}
__device__ __forceinline__ void final_norm_phase_h(const Frame& F, const bf16* h, float* out, const float* g) {
    const int lane_ = ltid() & 63;
    const int gw = F.vcu * NWAVES + F.wave, NGW = F.G * NWAVES;
    for (int grp = gw; grp < M / 8; grp += NGW) {
        const GAS v4u* xr = (const GAS v4u*)(h + (size_t)grp * 8 * D) + lane_; GAS f32x4* orow = (GAS f32x4*)(out + (size_t)grp * 8 * D) + 2 * lane_;
        v4u va[4][4], vb[4][4];
#pragma unroll
        for (int r = 0; r < 4; ++r)
#pragma unroll
            for (int j = 0; j < 4; ++j) va[r][j] = xr[(size_t)r * (D / 8) + 64 * j];
#pragma unroll
        for (int r = 0; r < 4; ++r)
#pragma unroll
            for (int j = 0; j < 4; ++j) vb[r][j] = xr[(size_t)(r + 4) * (D / 8) + 64 * j];
        f32x4 gg[4][2];
#pragma unroll
        for (int j = 0; j < 4; ++j)
#pragma unroll
            for (int n = 0; n < 2; ++n) gg[j][n] = *(const GAS f32x4*)(g + 8 * lane_ + 512 * j + 4 * n);
#define FNH_PROC(v, r) { const float rstd = 1.0f / sqrtf(row_sumsq_h(v) * (1.0f / D) + RMS_EPS); \
            _Pragma("unroll") for (int j = 0; j < 4; ++j) { const v4u w = v[j]; \
                const f32x4 x0 = {bflo(w.x), bfhi(w.x), bflo(w.y), bfhi(w.y)}, x1 = {bflo(w.z), bfhi(w.z), bflo(w.w), bfhi(w.w)}; \
                orow[(size_t)(r) * (D / 4) + 128 * j] = x0 * rstd * gg[j][0]; orow[(size_t)(r) * (D / 4) + 128 * j + 1] = x1 * rstd * gg[j][1]; } }
#pragma unroll
        for (int r = 0; r < 4; ++r) FNH_PROC(va[r], r)
#pragma unroll
        for (int r = 0; r < 4; ++r) FNH_PROC(vb[r], r + 4)
#undef FNH_PROC
    }
}

__device__ __forceinline__ void unpack8(const v4u w, float (&x)[8]) { x[0] = bflo(w.x); x[1] = bfhi(w.x); x[2] = bflo(w.y); x[3] = bfhi(w.y); x[4] = bflo(w.z); x[5] = bfhi(w.z); x[6] = bflo(w.w); x[7] = bfhi(w.w); }
__device__ __forceinline__ v4u pack8(const float (&x)[8]) { v4u o; o.x = pk2(x[0], x[1]); o.y = pk2(x[2], x[3]); o.z = pk2(x[4], x[5]); o.w = pk2(x[6], x[7]); return o; }

__device__ __forceinline__ void prep_phase(const Frame& F, const bf16* __restrict__ Z, const float* __restrict__ mu, const float* __restrict__ ckvg, bf16* __restrict__ LA, bf16* __restrict__ CKV) {
    const int gw = F.vcu * NWAVES + F.wave, NGW = F.G * NWAVES, lane = ltid() & 63;
    const int l5 = lane & 31, j0 = 8 * l5, hf = lane >> 5;
    for (int grp = gw; grp < M / 8; grp += NGW) {
        const int r0 = grp * 8 + 4 * hf;
        const bool hp = (r0 & (SEQ - 1)) != 0;
        const bf16* zb = Z + (size_t)r0 * NZ;
        v4u zw[3][5], cw[4];
#pragma unroll
        for (int which = 0; which < 3; ++which) {
            const int zcol = which == 0 ? ZC_WL : (which == 1 ? ZC_AL : ZC_GL), nval = which == 2 ? 256 : 96;
#pragma unroll
            for (int i = 0; i < 5; ++i) { zw[which][i] = (v4u){0u, 0u, 0u, 0u}; if (j0 < nval && (i > 0 || hp)) zw[which][i] = *(const GAS v4u*)(zb + (ptrdiff_t)(i - 1) * NZ + zcol + j0); } }
#pragma unroll
        for (int i = 0; i < 4; ++i) cw[i] = *(const GAS v4u*)(zb + (size_t)i * NZ + ZC_CKV + j0);
#pragma unroll
        for (int which = 0; which < 3; ++which) {
            const int moff = which == 0 ? 3072 : (which == 1 ? 3168 : 3264), nval = which == 2 ? 256 : 96;
            float mv[8];
#pragma unroll
            for (int j = 0; j < 8; ++j) mv[j] = (j0 < nval) ? mu[moff + j0 + j] : 0.f;
#pragma unroll
            for (int i = 0; i < 4; ++i) {
                float y[8] = {0.f, 0.f, 0.f, 0.f, 0.f, 0.f, 0.f, 0.f};
                if (j0 < nval) { float cc[8], pp[8]; unpack8(zw[which][i + 1], cc); unpack8(zw[which][i], pp);
#pragma unroll
                    for (int j = 0; j < 8; ++j) { const float zm = cc[j] + (pp[j] - cc[j]) * mv[j];
                        if (which == 0) { const float e = __expf(-2.0f * fabsf(zm)); const float th = (1.0f - e) / (1.0f + e); y[j] = zm < 0.f ? -th : th; }
                        else if (which == 1) y[j] = zm;
                        else y[j] = 1.0f / (1.0f + __expf(-zm)); } }
                *(GAS v4u*)(LA + (size_t)which * M * 256 + (size_t)(r0 + i) * 256 + j0) = pack8(y); }
        }
        {
            float gv[8];
#pragma unroll
            for (int j = 0; j < 8; ++j) gv[j] = ckvg[j0 + j];
#pragma unroll
            for (int i = 0; i < 4; ++i) { float cc[8]; unpack8(cw[i], cc);
                float ss = 0.f;
#pragma unroll
                for (int j = 0; j < 8; ++j) ss += cc[j] * cc[j];
#pragma unroll
                for (int o = 1; o < 32; o <<= 1) ss += __shfl_xor(ss, o);
                const float rstd = 1.0f / sqrtf(ss * (1.0f / 256.0f) + RMS_EPS);
                float y[8];
#pragma unroll
                for (int j = 0; j < 8; ++j) y[j] = cc[j] * rstd * gv[j];
                *(GAS v4u*)(CKV + (size_t)(r0 + i) * 256 + j0) = pack8(y); }
        }
    }
}

__device__ __forceinline__ float wave_sum_f(float x) {
    x += __builtin_bit_cast(float, __builtin_amdgcn_update_dpp(0, __builtin_bit_cast(int, x), 0xB1, 0xF, 0xF, true));
    x += __builtin_bit_cast(float, __builtin_amdgcn_update_dpp(0, __builtin_bit_cast(int, x), 0x4E, 0xF, 0xF, true));
    x += __builtin_bit_cast(float, __builtin_amdgcn_update_dpp(0, __builtin_bit_cast(int, x), 0x141, 0xF, 0xF, true));
    x += __builtin_bit_cast(float, __builtin_amdgcn_update_dpp(0, __builtin_bit_cast(int, x), 0x140, 0xF, 0xF, true));
    const int xi = __builtin_bit_cast(int, x);
    return (__builtin_bit_cast(float, __builtin_amdgcn_readlane(xi, 0)) + __builtin_bit_cast(float, __builtin_amdgcn_readlane(xi, 16))) +
           (__builtin_bit_cast(float, __builtin_amdgcn_readlane(xi, 32)) + __builtin_bit_cast(float, __builtin_amdgcn_readlane(xi, 48)));
}
__device__ __forceinline__ unsigned wave_sum_u(unsigned x) {
    x += (unsigned)__builtin_amdgcn_update_dpp(0, (int)x, 0xB1, 0xF, 0xF, true);
    x += (unsigned)__builtin_amdgcn_update_dpp(0, (int)x, 0x4E, 0xF, 0xF, true);
    x += (unsigned)__builtin_amdgcn_update_dpp(0, (int)x, 0x141, 0xF, 0xF, true);
    x += (unsigned)__builtin_amdgcn_update_dpp(0, (int)x, 0x140, 0xF, 0xF, true);
    return (unsigned)__builtin_amdgcn_readlane((int)x, 0) + (unsigned)__builtin_amdgcn_readlane((int)x, 16) + (unsigned)__builtin_amdgcn_readlane((int)x, 32) + (unsigned)__builtin_amdgcn_readlane((int)x, 48);
}
__device__ __forceinline__ unsigned wave_incl_scan(unsigned x) {
    x += (unsigned)__builtin_amdgcn_update_dpp(0, (int)x, 0x111, 0xF, 0xF, false);
    x += (unsigned)__builtin_amdgcn_update_dpp(0, (int)x, 0x112, 0xF, 0xF, false);
    x += (unsigned)__builtin_amdgcn_update_dpp(0, (int)x, 0x114, 0xF, 0xF, false);
    x += (unsigned)__builtin_amdgcn_update_dpp(0, (int)x, 0x118, 0xF, 0xF, false);
    x += (unsigned)__builtin_amdgcn_update_dpp(0, (int)x, 0x142, 0xA, 0xF, false);
    x += (unsigned)__builtin_amdgcn_update_dpp(0, (int)x, 0x143, 0xC, 0xF, false);
    return x;
}
__device__ __forceinline__ unsigned fkey(float f) { const unsigned u = __builtin_bit_cast(unsigned, f); return (u & 0x80000000u) ? ~u : (u | 0x80000000u); }
template <int REP_SC, int REP_SEL>
__device__ __forceinline__ void topk_phase(const Frame& F, const bf16* __restrict__ Z, unsigned short* __restrict__ IDX) {
    LAS float* SC = (LAS float*)F.lds;
    const int lane = ltid() & 63, w = F.wave, hl = lane >> 5, ln = lane & 31;
    const int qq = (ln >> 2) & 1, hh = (ln & 3) + 4 * (ln >> 3);
    const unsigned long long lt_mask = (1ull << lane) - 1ull;
    bf16x8 A[4][4]; v4u wp[4][2];
#define TK_LOAD_Q(m0_) { _Pragma("unroll") for (int mt = 0; mt < 4; ++mt) { \
            _Pragma("unroll") for (int ks = 0; ks < 4; ++ks) A[mt][ks] = *(const GAS bf16x8*)(Z + (size_t)((m0_) + 2 * mt + qq) * NZ + ZC_QIDX + hh * 64 + 16 * ks + 8 * hl); } }
    if (F.vcu < M / 8) TK_LOAD_Q(F.vcu * 8)
    for (int ui = 0; ui * F.G < M / 8; ++ui) {
        const int unit = ui * F.G + ((ui & 1) ? (F.G - 1 - F.vcu) : F.vcu);
        if (unit >= M / 8) break;
        const int m0 = unit * 8, t0 = m0 & (SEQ - 1);
        const bf16* Zb = Z + (size_t)(m0 - t0) * NZ;
#pragma unroll
        for (int mt = 0; mt < 4; ++mt) { wp[mt][0] = *(const GAS v4u*)(Z + (size_t)(m0 + 2 * mt + hl) * NZ + ZC_WIDX); wp[mt][1] = *(const GAS v4u*)(Z + (size_t)(m0 + 2 * mt + hl) * NZ + ZC_WIDX + 8); }
        const int nkt = (t0 + 7) / 32 + 1;
        for (int rep_sc = 0; rep_sc < REP_SC; ++rep_sc) {
            const bool extra = rep_sc > 0;
            constexpr bool X_NOLOAD = (REPK == 63 || REPK == 66), X_NOMMA = (REPK == 64 || REPK == 65), X_NOEPI = (REPK == 65);
            bf16x8 Bn[4];
            if (w < nkt) { const bf16* kp = Zb + (size_t)(w * 32 + ln) * NZ + ZC_KIDX + 8 * hl;
#pragma unroll
                for (int ks = 0; ks < 4; ++ks) Bn[ks] = *(const GAS bf16x8*)(kp + 16 * ks); }
            unsigned sink = 0u;
            for (int kt = w; kt < nkt; kt += NWAVES) {
                bf16x8 Bf[4];
#pragma unroll
                for (int ks = 0; ks < 4; ++ks) Bf[ks] = Bn[ks];
                if (kt + NWAVES < nkt && !(extra && X_NOLOAD)) { const bf16* kp = Zb + (size_t)((kt + NWAVES) * 32 + ln) * NZ + ZC_KIDX + 8 * hl;
#pragma unroll
                    for (int ks = 0; ks < 4; ++ks) Bn[ks] = *(const GAS bf16x8*)(kp + 16 * ks); }
                if (extra && X_NOEPI) {
#pragma unroll
                    for (int ks = 0; ks < 4; ++ks) sink ^= (unsigned)Bf[ks][0];
                    continue; }
                if (extra && REPK == 66) {
                    unsigned xs[8];
#pragma unroll
                    for (int i = 0; i < 8; ++i) xs[i] = (unsigned)Bf[i & 3][i >> 2] + sink;
#pragma unroll
                    for (int r = 0; r < 32; ++r) {
#pragma unroll
                        for (int i = 0; i < 8; ++i) { xs[i] ^= (unsigned)kt; xs[i] += 0x9e3779b9u + (unsigned)lane; } }
#pragma unroll
                    for (int i = 0; i < 8; ++i) sink ^= xs[i];
                    continue; }
#pragma unroll
                for (int mt = 0; mt < 4; ++mt) {
                    f32x16 acc;
#pragma unroll
                    for (int i = 0; i < 16; ++i) acc[i] = 0.f;
                    if (!(extra && X_NOMMA)) {
#pragma unroll
                        for (int ks = 0; ks < 4; ++ks) acc = __builtin_amdgcn_mfma_f32_32x32x16_bf16(A[mt][ks], Bf[ks], acc, 0, 0, 0);
                    } else { acc[0] = __builtin_bit_cast(float, (unsigned)Bf[mt][1] << 16); acc[5] = __builtin_bit_cast(float, (unsigned)Bf[mt][2] << 16); }
                    float s = 0.f;
                    typedef short s16x2 __attribute__((ext_vector_type(2)));
#pragma unroll
                    for (int p2 = 0; p2 < 8; ++p2) { const unsigned pk = pk2(acc[2 * p2], acc[2 * p2 + 1]);
                        const s16x2 rl = __builtin_elementwise_max(__builtin_bit_cast(s16x2, pk), (s16x2){0, 0});
                        const unsigned wv = wp[mt][p2 >> 2][p2 & 3];
                        s = __builtin_amdgcn_fdot2_f32_bf16(__builtin_bit_cast(hwbf2, rl), __builtin_bit_cast(hwbf2, wv), s, false); }
                    if (extra && REPK != 61) ((LAS float*)(F.lds + 131072))[lane] = s; else SC[(2 * mt + hl) * SEQ + kt * 32 + ln] = s;
                }
            }
            if (extra && (X_NOEPI || REPK == 66)) ((LAS unsigned*)(F.lds + 131072))[lane] = sink;
        }
        __syncthreads();
        { const int un_ = (ui + 1) * F.G + (((ui + 1) & 1) ? (F.G - 1 - F.vcu) : F.vcu); if ((ui + 1) * F.G < M / 8 && un_ < M / 8) TK_LOAD_Q(un_ * 8) }
        for (int rep_sel = 0; rep_sel < REP_SEL; ++rep_sel)
        {
            const int m = m0 + w, nv = t0 + w + 1;
            unsigned u[64];
#pragma unroll
            for (int i = 0; i < 64; ++i) u[i] = __builtin_bit_cast(unsigned, SC[w * SEQ + lane + 64 * i]);
#pragma unroll
            for (int i = 0; i < 64; ++i) { const unsigned x = u[i]; const unsigned kx = (x & 0x80000000u) ? ~x : (x | 0x80000000u); u[i] = (lane + 64 * i < nv) ? (kx >> 1) : 0u; }
            unsigned T = 1u; int need_eq = 0;
            if (nv > TOPK) {
                T = 0u; bool exact = false;
                const int nreg = (nv > 3072) ? 64 : (nv > 2048 ? 48 : (nv > 1024 ? 32 : 16));
                for (int bit = 30; bit >= 0; --bit) {
                    const unsigned cand = T | (1u << bit); unsigned clt = 0u;
#pragma unroll
                    for (int g4 = 0; g4 < 4; ++g4) if (g4 * 1024 < nv) { unsigned acc = 0u;
#pragma unroll
                        for (int i = 16 * g4; i < 16 * g4 + 16; ++i) acc = __builtin_amdgcn_alignbit(acc, u[i] - cand, 31);
                        clt += (unsigned)__popc(acc); }
                    const int cnt = 64 * nreg - (int)wave_sum_u(clt);
                    if (cnt >= TOPK) { T = cand; if (cnt == TOPK) { exact = true; break; } }
                }
                if (exact) { T -= 1u; need_eq = 0; }
                else { unsigned c = 0u;
#pragma unroll
                    for (int i = 0; i < 64; ++i) c += (u[i] > T) ? 1u : 0u;
                    need_eq = TOPK - (int)wave_sum_u(c); }
            }
            LAS unsigned short* stage = (LAS unsigned short*)(SC + w * SEQ);
            int base = 0;
            if (need_eq == 0) {
#pragma unroll
                for (int g4 = 0; g4 < 4; ++g4) if (g4 * 1024 < nv) {
#pragma unroll
                    for (int i = 16 * g4; i < 16 * g4 + 16; ++i) {
                        const bool sel = u[i] > T; const unsigned long long ms = __ballot(sel);
                        const int pos = base + (int)__builtin_amdgcn_mbcnt_hi((unsigned)(ms >> 32), __builtin_amdgcn_mbcnt_lo((unsigned)ms, 0u));
                        if (sel) stage[pos] = (unsigned short)(lane + 64 * i);
                        base += __popcll(ms);
                    } }
            } else {
                int eqseen = 0;
#pragma unroll
                for (int g4 = 0; g4 < 4; ++g4) if (g4 * 1024 < nv) {
#pragma unroll
                    for (int i = 16 * g4; i < 16 * g4 + 16; ++i) {
                        const bool gt = u[i] > T, eq = (u[i] == T);
                        const unsigned long long meq = __ballot(eq);
                        const int eqr = eqseen + __popcll(meq & lt_mask);
                        const bool sel = gt || (eq && eqr < need_eq);
                        const unsigned long long ms = __ballot(sel);
                        const int pos = base + __popcll(ms & lt_mask);
                        if (sel && pos < TOPK) stage[pos] = (unsigned short)(lane + 64 * i);
                        base += __popcll(ms); eqseen += __popcll(meq);
                    } }
            }
            for (int p = base + lane; p < TOPK; p += 64) stage[p] = (unsigned short)0xFFFFu;
            LDS_WAIT();
            *(GAS v2u*)(IDX + (size_t)m * TOPK + 4 * lane) = *(const LAS v2u*)(stage + 4 * lane);
        }
        __syncthreads();
    }
}

#undef TK_LOAD_Q
template <int OFF> __device__ __forceinline__ bf16x4 tr_read4(unsigned lds_addr) { bf16x4 r; asm volatile("ds_read_b64_tr_b16 %0, %1 offset:%2\n\ts_waitcnt lgkmcnt(0)" : "=&v"(r) : "v"(lds_addr), "n"(OFF) : "memory"); return r; }
constexpr int AT_BP = 1056, AT_IDX = 16 * AT_BP, AT_TILE = AT_IDX + 1024, AT_TB = SCR_BYTES + 1024, AT_LUT = AT_TB + 1024;
static_assert(NWAVES * AT_TILE <= SCR_BYTES && AT_LUT + 132 <= LDS_BYTES && MISC_OFF + 128 <= AT_TB, "attention LDS");
__device__ __forceinline__ float xrow_max(float x) {
    const unsigned xi = __builtin_bit_cast(unsigned, x); const auto a = __builtin_amdgcn_permlane16_swap(xi, xi, false, false);
    const float m = fmaxf(__builtin_bit_cast(float, a[0]), __builtin_bit_cast(float, a[1])); const unsigned mi = __builtin_bit_cast(unsigned, m);
    const auto b = __builtin_amdgcn_permlane32_swap(mi, mi, false, false); return fmaxf(__builtin_bit_cast(float, b[0]), __builtin_bit_cast(float, b[1])); }
__device__ __forceinline__ float xrow_sum(float x) {
    const unsigned xi = __builtin_bit_cast(unsigned, x); const auto a = __builtin_amdgcn_permlane16_swap(xi, xi, false, false);
    const float m = __builtin_bit_cast(float, a[0]) + __builtin_bit_cast(float, a[1]); const unsigned mi = __builtin_bit_cast(unsigned, m);
    const auto b = __builtin_amdgcn_permlane32_swap(mi, mi, false, false); return __builtin_bit_cast(float, b[0]) + __builtin_bit_cast(float, b[1]); }
__device__ __forceinline__ void attn_setup(const Frame& F, const float* t5) {
    LAS float* tb = (LAS float*)(F.lds + AT_TB); LAS unsigned char* lut = F.lds + AT_LUT;
    for (int i = ltid(); i < 256; i += NTHR) tb[i] = t5[i];
    for (int n = ltid(); n < 132; n += NTHR) {
        int bk = n; if (n >= 16) { bk = 16 + (int)(__log2f((float)n * 0.0625f) * 5.33333333f); bk = bk > 31 ? 31 : bk; }
        lut[n] = (unsigned char)bk; }
    __syncthreads();
}
__device__ __forceinline__ void attn_phase(const Frame& F, const bf16* __restrict__ Z, const bf16* __restrict__ CKV, const unsigned short* __restrict__ IDX, const float* __restrict__ t5, bf16* __restrict__ O, unsigned* __restrict__ wq) {
    LAS unsigned char* tile = F.lds + F.wave * AT_TILE;
    LAS unsigned short* idxl = (LAS unsigned short*)(tile + AT_IDX);
    LAS float* tb = (LAS float*)(F.lds + AT_TB); const LAS unsigned char* lut = F.lds + AT_LUT;
    LAS unsigned short* idxs = idxl + 256;
    const int lane = ltid() & 63, g = lane >> 4, i16 = lane & 15, q = i16 >> 2, p = i16 & 3, hd = i16 & 7, half = lane >> 5;
    const unsigned tbase = (unsigned)(size_t)tile;
    const int sh0 = (int)(xb_xcc_id() & 7u);
    for (int ss = 0; ss < 8; ++ss) {
      const int shard = (sh0 + ss) & 7;
      for (;;) {
        int item = 0; if (lane == 0) item = (int)__hip_atomic_fetch_add(wq + 64 * shard, 1u, RLX_AGENT);
        item = __builtin_amdgcn_readfirstlane(item);
        if (item >= M / 8) break;
        const int m = shard * (M / 8) + item;
        const int t = m & (SEQ - 1); const size_t brow = (size_t)(m - t);
        { const v2u iv = *(const GAS v2u*)(IDX + (size_t)m * TOPK + 4 * lane); *(LAS v2u*)(idxl + 4 * lane) = iv;
          v2u sv; sv.x = (((iv.x & 0xFFFFu) == 0xFFFFu) ? 0u : (iv.x & 0xFFFFu)) | (((iv.x >> 16) == 0xFFFFu) ? 0u : (iv.x & 0xFFFF0000u));
          sv.y = (((iv.y & 0xFFFFu) == 0xFFFFu) ? 0u : (iv.y & 0xFFFFu)) | (((iv.y >> 16) == 0xFFFFu) ? 0u : (iv.y & 0xFFFF0000u));
          *(LAS v2u*)(idxs + 4 * lane) = sv; }
        bf16x8 qf[8];
#pragma unroll
        for (int ks = 0; ks < 8; ++ks) { const bf16x8 v = *(const GAS bf16x8*)(Z + (size_t)m * NZ + hd * 256 + 32 * ks + 8 * g); qf[ks] = (i16 < 8) ? v : (bf16x8){0, 0, 0, 0, 0, 0, 0, 0}; }
        f32x4 oacc[16];
#pragma unroll
        for (int c = 0; c < 16; ++c) oacc[c] = (f32x4){0.f, 0.f, 0.f, 0.f};
        float mrun = -INFINITY, lrun = 0.f;
        const bf16* gb = CKV + brow * 256 + (lane & 31) * 8;
        LDS_WAIT();
#define AT_GATHER(chv) { const v4u i0_ = *(const LAS v4u*)(idxs + (chv) * 32 + 16 * half), i1_ = *(const LAS v4u*)(idxs + (chv) * 32 + 16 * half + 8); \
            const unsigned iw_[8] = {i0_.x, i0_.y, i0_.z, i0_.w, i1_.x, i1_.y, i1_.z, i1_.w}; \
            _Pragma("unroll") for (int j = 0; j < 16; ++j) { const unsigned kid_ = (j & 1) ? (iw_[j >> 1] >> 16) : (iw_[j >> 1] & 0xFFFFu); \
                __builtin_amdgcn_global_load_lds((const unsigned*)(gb + ((size_t)kid_ << 8)), (LAS unsigned*)(tile + j * AT_BP), 16, 0, 0); } }
        AT_GATHER(0)
        for (int ch = 0; ch < 8; ++ch) {
            asm volatile("s_waitcnt vmcnt(0)" ::: "memory");
            f32x4 lg[2];
#pragma unroll
            for (int mt = 0; mt < 2; ++mt) { f32x4 a_ = {0.f, 0.f, 0.f, 0.f};
#pragma unroll
                for (int ks = 0; ks < 8; ++ks) { const bf16x8 cf = *(const LAS bf16x8*)(tile + i16 * AT_BP + 512 * mt + 64 * ks + 16 * g); a_ = __builtin_amdgcn_mfma_f32_16x16x32_bf16(cf, qf[ks], a_, 0, 0, 0); }
                lg[mt] = a_; }
            bf16x8 pv[16];
            const unsigned trb = tbase + (unsigned)((4 * g + q) * AT_BP + 8 * p);
#define AT_TR4(c0) { bf16x4 l0, h0, l1, h1, l2, h2, l3, h3; \
                asm volatile("ds_read_b64_tr_b16 %0, %8 offset:%9\n\tds_read_b64_tr_b16 %1, %8 offset:%10\n\tds_read_b64_tr_b16 %2, %8 offset:%11\n\tds_read_b64_tr_b16 %3, %8 offset:%12\n\t" \
                             "ds_read_b64_tr_b16 %4, %8 offset:%13\n\tds_read_b64_tr_b16 %5, %8 offset:%14\n\tds_read_b64_tr_b16 %6, %8 offset:%15\n\tds_read_b64_tr_b16 %7, %8 offset:%16\n\ts_waitcnt lgkmcnt(0)" \
                             : "=&v"(l0), "=&v"(h0), "=&v"(l1), "=&v"(h1), "=&v"(l2), "=&v"(h2), "=&v"(l3), "=&v"(h3) \
                             : "v"(trb), "n"(32 * (c0)), "n"(512 + 32 * (c0)), "n"(32 * ((c0) + 1)), "n"(512 + 32 * ((c0) + 1)), "n"(32 * ((c0) + 2)), "n"(512 + 32 * ((c0) + 2)), "n"(32 * ((c0) + 3)), "n"(512 + 32 * ((c0) + 3)) : "memory"); \
                pv[(c0)] = __builtin_shufflevector(l0, h0, 0, 1, 2, 3, 4, 5, 6, 7); pv[(c0) + 1] = __builtin_shufflevector(l1, h1, 0, 1, 2, 3, 4, 5, 6, 7); \
                pv[(c0) + 2] = __builtin_shufflevector(l2, h2, 0, 1, 2, 3, 4, 5, 6, 7); pv[(c0) + 3] = __builtin_shufflevector(l3, h3, 0, 1, 2, 3, 4, 5, 6, 7); }
            AT_TR4(0) AT_TR4(4) AT_TR4(8) AT_TR4(12)
#undef AT_TR4
            if (ch < 7) AT_GATHER(ch + 1)
            float pr[2][4]; float cm = -INFINITY;
#pragma unroll
            for (int mt = 0; mt < 2; ++mt) { const v2u iw = *(const LAS v2u*)(idxl + ch * 32 + 16 * mt + 4 * g);
#pragma unroll
                for (int r = 0; r < 4; ++r) { const unsigned kv = ((r & 2) ? iw.y : iw.x) >> ((r & 1) * 16) & 0xFFFFu;
                    const unsigned dist = (unsigned)(t - (int)kv);
                    const unsigned bk = lut[dist < 128u ? dist : 128u];
                    float x = lg[mt][r] + tb[bk * 8 + hd];
                    x = (kv == 0xFFFFu) ? -INFINITY : x;
                    pr[mt][r] = x; cm = fmaxf(cm, x); } }
            cm = fmaxf(cm, __shfl_xor(cm, 16)); cm = fmaxf(cm, __shfl_xor(cm, 32));
            const float mnew = fmaxf(mrun, cm);
            const float alpha = __expf(mrun - mnew);
            float ls = 0.f;
#pragma unroll
            for (int mt = 0; mt < 2; ++mt)
#pragma unroll
                for (int r = 0; r < 4; ++r) { const float e = __expf(pr[mt][r] - mnew); pr[mt][r] = e; ls += e; }
            ls += __shfl_xor(ls, 16); ls += __shfl_xor(ls, 32);
            lrun = lrun * alpha + ls; mrun = mnew;
            v4u pw; pw.x = pk2(pr[0][0], pr[0][1]); pw.y = pk2(pr[0][2], pr[0][3]); pw.z = pk2(pr[1][0], pr[1][1]); pw.w = pk2(pr[1][2], pr[1][3]);
            const bf16x8 pf = __builtin_bit_cast(bf16x8, pw);
            if (__builtin_amdgcn_readfirstlane(__ballot(alpha != 1.0f) != 0ull)) {
#pragma unroll
                for (int c = 0; c < 16; ++c) oacc[c] = oacc[c] * alpha; }
#pragma unroll
            for (int c = 0; c < 16; ++c) oacc[c] = __builtin_amdgcn_mfma_f32_16x16x32_bf16(pv[c], pf, oacc[c], 0, 0, 0);
        }
#undef AT_GATHER
        const float inv = 1.0f / lrun;
        if (i16 < 8) {
            bf16* op = O + (size_t)m * KO + hd * 256 + 4 * g;
#pragma unroll
            for (int c = 0; c < 16; ++c) { v2u o; o.x = pk2(oacc[c][0] * inv, oacc[c][1] * inv); o.y = pk2(oacc[c][2] * inv, oacc[c][3] * inv); *(GAS v2u*)(op + 16 * c) = o; }
        }
      }
    }
}

constexpr int CP = 144;
constexpr int CSLOT = 64 * CP;
constexpr int S_A = 0, S_B = 1, S_K = 2, S_R = 3, S_V = 4, S_LAK = 5, S_MBR = 6, S_MKR = 7, S_T = 8, S_TH = 9, S_PH = 10, S_L = 11, S_TB = 12, S_LA = 13, S_LB = 14, S_G2 = S_B, S_OM = S_MBR;
constexpr int C_GC = 15 * CSLOT;
static_assert(C_GC + 256 + 2048 <= SCR_BYTES, "chunk phase LDS");
__device__ __forceinline__ bf16x8 rowfrag(LAS unsigned char* slot, int tile, int ks, int ln, int hl) { return *(const LAS bf16x8*)(slot + (32 * tile + ln) * CP + 32 * ks + 16 * hl); }
__device__ __forceinline__ void trfrag4(unsigned a, bf16x8 (&f)[4]) {
    bf16x4 l0, h0, l1, h1, l2, h2, l3, h3;
    asm volatile("ds_read_b64_tr_b16 %0, %8 offset:%9\n\tds_read_b64_tr_b16 %1, %8 offset:%10\n\tds_read_b64_tr_b16 %2, %8 offset:%11\n\tds_read_b64_tr_b16 %3, %8 offset:%12\n\t"
                 "ds_read_b64_tr_b16 %4, %8 offset:%13\n\tds_read_b64_tr_b16 %5, %8 offset:%14\n\tds_read_b64_tr_b16 %6, %8 offset:%15\n\tds_read_b64_tr_b16 %7, %8 offset:%16\n\ts_waitcnt lgkmcnt(0)"
                 : "=&v"(l0), "=&v"(h0), "=&v"(l1), "=&v"(h1), "=&v"(l2), "=&v"(h2), "=&v"(l3), "=&v"(h3)
                 : "v"(a), "n"(0), "n"(4 * CP), "n"(16 * CP), "n"(20 * CP), "n"(32 * CP), "n"(36 * CP), "n"(48 * CP), "n"(52 * CP) : "memory");
    f[0] = __builtin_shufflevector(l0, h0, 0, 1, 2, 3, 4, 5, 6, 7); f[1] = __builtin_shufflevector(l1, h1, 0, 1, 2, 3, 4, 5, 6, 7);
    f[2] = __builtin_shufflevector(l2, h2, 0, 1, 2, 3, 4, 5, 6, 7); f[3] = __builtin_shufflevector(l3, h3, 0, 1, 2, 3, 4, 5, 6, 7);
}
__device__ __forceinline__ void trfrag4x2(unsigned a, unsigned b, bf16x8 (&fa)[4], bf16x8 (&fb)[4]) {
    bf16x4 l0, h0, l1, h1, l2, h2, l3, h3, m0, n0, m1, n1, m2, n2, m3, n3;
    asm volatile("ds_read_b64_tr_b16 %0, %16 offset:%18\n\tds_read_b64_tr_b16 %1, %16 offset:%19\n\tds_read_b64_tr_b16 %2, %16 offset:%20\n\tds_read_b64_tr_b16 %3, %16 offset:%21\n\t"
                 "ds_read_b64_tr_b16 %4, %16 offset:%22\n\tds_read_b64_tr_b16 %5, %16 offset:%23\n\tds_read_b64_tr_b16 %6, %16 offset:%24\n\tds_read_b64_tr_b16 %7, %16 offset:%25\n\t"
                 "ds_read_b64_tr_b16 %8, %17 offset:%18\n\tds_read_b64_tr_b16 %9, %17 offset:%19\n\tds_read_b64_tr_b16 %10, %17 offset:%20\n\tds_read_b64_tr_b16 %11, %17 offset:%21\n\t"
                 "ds_read_b64_tr_b16 %12, %17 offset:%22\n\tds_read_b64_tr_b16 %13, %17 offset:%23\n\tds_read_b64_tr_b16 %14, %17 offset:%24\n\tds_read_b64_tr_b16 %15, %17 offset:%25\n\ts_waitcnt lgkmcnt(0)"
                 : "=&v"(l0), "=&v"(h0), "=&v"(l1), "=&v"(h1), "=&v"(l2), "=&v"(h2), "=&v"(l3), "=&v"(h3), "=&v"(m0), "=&v"(n0), "=&v"(m1), "=&v"(n1), "=&v"(m2), "=&v"(n2), "=&v"(m3), "=&v"(n3)
                 : "v"(a), "v"(b), "n"(0), "n"(4 * CP), "n"(16 * CP), "n"(20 * CP), "n"(32 * CP), "n"(36 * CP), "n"(48 * CP), "n"(52 * CP) : "memory");
    fa[0] = __builtin_shufflevector(l0, h0, 0, 1, 2, 3, 4, 5, 6, 7); fa[1] = __builtin_shufflevector(l1, h1, 0, 1, 2, 3, 4, 5, 6, 7);
    fa[2] = __builtin_shufflevector(l2, h2, 0, 1, 2, 3, 4, 5, 6, 7); fa[3] = __builtin_shufflevector(l3, h3, 0, 1, 2, 3, 4, 5, 6, 7);
    fb[0] = __builtin_shufflevector(m0, n0, 0, 1, 2, 3, 4, 5, 6, 7); fb[1] = __builtin_shufflevector(m1, n1, 0, 1, 2, 3, 4, 5, 6, 7);
    fb[2] = __builtin_shufflevector(m2, n2, 0, 1, 2, 3, 4, 5, 6, 7); fb[3] = __builtin_shufflevector(m3, n3, 0, 1, 2, 3, 4, 5, 6, 7);
}
__device__ __forceinline__ unsigned trbase(LAS unsigned char* slot, int tile, int lane) { const int hl = lane >> 5, blk = (lane >> 4) & 1, q = (lane & 15) >> 2, p = lane & 3;
    return (unsigned)(size_t)slot + (unsigned)((8 * hl + q) * CP + 64 * tile + 32 * blk + 8 * p); }
template <int AM, int BM> __device__ __forceinline__ void mm_fetch(LAS unsigned char* sa, int ta, LAS unsigned char* sb, int tb, bf16x8 (&a)[4], bf16x8 (&b)[4], int lane) {
    const int ln = lane & 31, hl = lane >> 5;
    const unsigned tra = trbase(sa, ta, lane), trb = trbase(sb, tb, lane);
    if constexpr (BM == 0) {
#pragma unroll
        for (int ks = 0; ks < 4; ++ks) b[ks] = rowfrag(sb, tb, ks, ln, hl);
    }
    if constexpr (AM != 0 && BM != 0) trfrag4x2(tra, trb, a, b);
    else {
        if constexpr (AM == 0) {
#pragma unroll
            for (int ks = 0; ks < 4; ++ks) a[ks] = rowfrag(sa, ta, ks, ln, hl);
        } else trfrag4(tra, a);
        if constexpr (BM != 0) trfrag4(trb, b);
    }
}
template <int AM, int BM> __device__ __forceinline__ f32x16 mm_tile(LAS unsigned char* sa, int ta, LAS unsigned char* sb, int tb, f32x16 acc, int lane) {
    bf16x8 a[4], b[4];
    mm_fetch<AM, BM>(sa, ta, sb, tb, a, b, lane);
#pragma unroll
    for (int ks = 0; ks < 4; ++ks) acc = __builtin_amdgcn_mfma_f32_32x32x16_bf16(a[ks], b[ks], acc, 0, 0, 0);
    return acc;
}
template <int AM, int BM> __device__ __forceinline__ f32x16 mm_tile_c(LAS unsigned char* sa, int ta, LAS unsigned char* sb, int tb, LAS unsigned char* sc, int rt, int ct, int lane) {
    const int ln = lane & 31, hl = lane >> 5;
    v2u craw[4];
#pragma unroll
    for (int q4 = 0; q4 < 4; ++q4) craw[q4] = *(const LAS v2u*)(sc + (32 * ct + ln) * CP + (32 * rt + 8 * q4 + 4 * hl) * 2);
    bf16x8 a[4], b[4];
    mm_fetch<AM, BM>(sa, ta, sb, tb, a, b, lane);
    f32x16 acc;
#pragma unroll
    for (int q4 = 0; q4 < 4; ++q4) { acc[4 * q4] = bflo(craw[q4].x); acc[4 * q4 + 1] = bfhi(craw[q4].x); acc[4 * q4 + 2] = bflo(craw[q4].y); acc[4 * q4 + 3] = bfhi(craw[q4].y); }
#pragma unroll
    for (int ks = 0; ks < 4; ++ks) acc = __builtin_amdgcn_mfma_f32_32x32x16_bf16(a[ks], b[ks], acc, 0, 0, 0);
    return acc;
}
__device__ __forceinline__ int crow32(int reg, int hl) { return (reg & 3) + 8 * (reg >> 2) + 4 * hl; }
__device__ __forceinline__ void tile_store_T(LAS unsigned char* slot, int rt, int ct, const f32x16& v, int lane) {
    const int ln = lane & 31, hl = lane >> 5;
#pragma unroll
    for (int q4 = 0; q4 < 4; ++q4) { v2u o; o.x = pk2(v[4 * q4], v[4 * q4 + 1]); o.y = pk2(v[4 * q4 + 2], v[4 * q4 + 3]);
        *(LAS v2u*)(slot + (32 * ct + ln) * CP + (32 * rt + 8 * q4 + 4 * hl) * 2) = o; }
}
__device__ __forceinline__ f32x16 tile_load_T(LAS unsigned char* slot, int rt, int ct, int lane) {
    const int ln = lane & 31, hl = lane >> 5; f32x16 v;
#pragma unroll
    for (int q4 = 0; q4 < 4; ++q4) { const v2u o = *(const LAS v2u*)(slot + (32 * ct + ln) * CP + (32 * rt + 8 * q4 + 4 * hl) * 2);
        v[4 * q4] = bflo(o.x); v[4 * q4 + 1] = bfhi(o.x); v[4 * q4 + 2] = bflo(o.y); v[4 * q4 + 3] = bfhi(o.y); }
    return v;
}
__device__ __forceinline__ f32x16 zero16() { f32x16 v;
#pragma unroll
    for (int r = 0; r < 16; ++r) v[r] = 0.f;
    return v; }

template <int REPC>
__device__ __forceinline__ void chunk_phase(const Frame& F, const bf16* __restrict__ Z, const bf16* __restrict__ LAp, const bf16* __restrict__ WLp, const float* __restrict__ w0v, const float* __restrict__ a0v, const float* __restrict__ mu, const float* __restrict__ k_k, const float* __restrict__ k_a, const float* __restrict__ r_k,
                                            bf16* __restrict__ RHO, bf16* __restrict__ ZL, bf16* __restrict__ PT, bf16* __restrict__ QT, float* __restrict__ BON) {
    const int lane = ltid() & 63, ln = lane & 31, hl = lane >> 5;
#define WL() int w = F.wave; asm volatile("" : "+s"(w))
    LAS unsigned char* L = F.lds;
#define SLOT(s) (L + (s) * CSLOT)
    LAS float* GC = (LAS float*)(L + C_GC);
    float zr[9], zk[9], zv[9]; bf16x8 lfa[6], lfb[6];
#define CH_LOAD(tk) { const int b_ = (tk) >> 10, h_ = ((tk) >> 6) & 15, c_ = (tk) & 63; int w_ = F.wave; asm volatile("" : "+s"(w_)); const int t0w_ = 8 * w_, hc_ = h_ * 64 + lane; \
        const int tok_ = b_ * SEQ + c_ * CH; const bf16* zrow_ = Z + (size_t)(tok_ + t0w_) * NZ + hc_; \
        _Pragma("unroll") for (int q = 0; q < 9; ++q) { const bool ok_ = (q > 0) || (c_ * CH + t0w_ > 0); const bf16* rp_ = zrow_ + (ptrdiff_t)(q - 1) * NZ; \
            zr[q] = 0.f; zk[q] = 0.f; zv[q] = 0.f; if (ok_) { zr[q] = bf2f(rp_[ZC_R]); zk[q] = bf2f(rp_[ZC_K]); zv[q] = bf2f(rp_[ZC_V]); } } \
        const int mm_ = w_ >> 2, rt_ = (w_ >> 1) & 1, ct_ = w_ & 1; \
        const bf16* ap_ = LAp + (size_t)mm_ * M * 256 + (size_t)(tok_ + 32 * rt_ + ln) * 256 + 8 * hl; const bf16* bp_ = WLp + (size_t)mm_ * 1024 * 256 + (size_t)(h_ * 64 + 32 * ct_ + ln) * 256 + 8 * hl; \
        _Pragma("unroll") for (int ks = 0; ks < 6; ++ks) { lfa[ks] = *(const GAS bf16x8*)(ap_ + 16 * ks); lfb[ks] = *(const GAS bf16x8*)(bp_ + 16 * ks); } }
    if (F.vcu < BATCH * 16 * NCH) CH_LOAD(F.vcu)
    for (int repc = 0; repc < REPC; ++repc)
    for (int task = F.vcu; task < BATCH * 16 * NCH; task += F.G) {
        const int b = task >> 10, h = (task >> 6) & 15, c = task & 63;
        const int tok0 = b * SEQ + c * CH;
        const size_t base = (size_t)tok0 * 1024 + h * 64;
        const size_t tbo = (size_t)task * 4096;
        LAS float* DL = (LAS float*)SLOT(8);
        {
            WL();
            const int mm = w >> 2, rt = (w >> 1) & 1, ct = w & 1; const int jc = 32 * ct + ln;
            f32x16 d = zero16();
#pragma unroll
            for (int ks = 0; ks < 6; ++ks) d = __builtin_amdgcn_mfma_f32_32x32x16_bf16(lfa[ks], lfb[ks], d, 0, 0, 0);
            const float bias = mm ? a0v[h * 64 + jc] : w0v[h * 64 + jc];
#pragma unroll
            for (int r = 0; r < 16; ++r) { const float x = d[r] + bias; float y;
                if (mm == 0) { const float nx = -x; const float sp = fmaxf(nx, 0.f) + 0.69314718056f * __builtin_amdgcn_logf(1.0f + __builtin_amdgcn_exp2f(-1.44269504089f * fabsf(nx)));
                    y = __builtin_amdgcn_exp2f(-1.44269504089f * __builtin_amdgcn_exp2f(-1.44269504089f * (sp + 0.5f))); }
                else y = __builtin_amdgcn_rcpf(1.0f + __builtin_amdgcn_exp2f(-1.44269504089f * x));
                DL[mm * 4096 + (32 * rt + crow32(r, hl)) * 64 + jc] = y; }
        }
        __syncthreads();
        {
            WL();
            const int t0w = 8 * w; const int hc = h * 64 + lane;
            const float mur = mu[hc], muk = mu[1024 + hc], muv = mu[2048 + hc], kkc = k_k[hc], kac = k_a[hc], rkc = r_k[hc];
            float wo[8], a8[8];
#pragma unroll
            for (int tt = 0; tt < 8; ++tt) { wo[tt] = DL[(t0w + tt) * 64 + lane]; a8[tt] = DL[4096 + (t0w + tt) * 64 + lane]; }
            float k8[8], b8[8], kk8[8], r8[8], v8[8]; float bonv = 0.f;
#pragma unroll
            for (int tt = 0; tt < 8; ++tt) {
                const float r = zr[tt + 1] + (zr[tt] - zr[tt + 1]) * mur, km = zk[tt + 1] + (zk[tt] - zk[tt + 1]) * muk, vv = zv[tt + 1] + (zv[tt] - zv[tt + 1]) * muv;
                const float kr = km * kkc; const float ss = wave_sum_f(kr * kr); const float kk = kr * (1.0f / fmaxf(sqrtf(ss), 1e-12f));
                const float a = a8[tt]; const float kp = km * (1.0f + (a - 1.0f) * kac);
                const float bon = wave_sum_f(r * kp * rkc); bonv = (lane == tt) ? bon : bonv;
                r8[tt] = r; v8[tt] = vv; k8[tt] = kp; kk8[tt] = kk; b8[tt] = kk * a; }
            if (lane < 8) BON[(size_t)task * 64 + t0w + lane] = bonv;
            float pw = wo[0];
#pragma unroll
            for (int tt = 1; tt < 8; ++tt) pw *= wo[tt];
            LAS float* PW = (LAS float*)(L + C_GC + 256);
            PW[w * 64 + lane] = pw;
            __syncthreads();
            float g = 1.0f;
#pragma unroll
            for (int ww = 0; ww < 7; ++ww) { const float pv = PW[ww * 64 + lane]; g = (ww < w) ? g * pv : g; }
            float xa[8], xb[8], xk[8], xr[8];
#pragma unroll
            for (int tt = 0; tt < 8; ++tt) { const float gp = g; g *= wo[tt]; const float ig = __builtin_amdgcn_rcpf(g);
                xa[tt] = -gp * kk8[tt]; xb[tt] = b8[tt] * ig; xk[tt] = k8[tt] * ig; xr[tt] = r8[tt] * g; }
            *(LAS v4u*)(SLOT(S_A) + lane * CP + 16 * w) = pack8(xa); *(LAS v4u*)(SLOT(S_B) + lane * CP + 16 * w) = pack8(xb);
            *(LAS v4u*)(SLOT(S_K) + lane * CP + 16 * w) = pack8(xk); *(LAS v4u*)(SLOT(S_R) + lane * CP + 16 * w) = pack8(xr);
            *(LAS v4u*)(SLOT(S_V) + lane * CP + 16 * w) = pack8(v8);
            if (w == 7) GC[lane] = g;
            { const int nt_ = (task + F.G < BATCH * 16 * NCH) ? task + F.G : ((repc + 1 < REPC) ? F.vcu : -1); if (nt_ >= 0) CH_LOAD(nt_) }
        }
        __syncthreads();
#pragma unroll
        for (int jj = 0; jj < 2; ++jj) {
            WL();
            const int job = 2 * w + jj, mm = job >> 2, rt = (job >> 1) & 1, ct = job & 1;
            LAS unsigned char* sa = (mm & 1) ? SLOT(S_K) : SLOT(S_B); LAS unsigned char* sb = (mm & 2) ? SLOT(S_R) : SLOT(S_A);
            f32x16 d = mm_tile<1, 1>(sa, rt, sb, ct, zero16(), lane);
            const int tcol = 32 * ct + ln;
#pragma unroll
            for (int r = 0; r < 16; ++r) { const int u = 32 * rt + crow32(r, hl); const bool keep = (mm <= 1) ? (u < tcol) : (u <= tcol); d[r] = keep ? d[r] : 0.f; }
            tile_store_T((mm == 0) ? SLOT(S_L) : ((mm == 1) ? SLOT(S_LAK) : (mm == 2 ? SLOT(S_MBR) : SLOT(S_MKR))), rt, ct, d, lane);
        }
        __syncthreads();
        {
            WL();
            const int rt = (w >> 1) & 1, ct = w & 1; const bool tw = w < 4;
            f32x16 tm = zero16();
            if (tw) { tm = tile_load_T(SLOT(S_L), rt, ct, lane);
#pragma unroll
                for (int r = 0; r < 16; ++r) tm[r] += (32 * rt + crow32(r, hl) == 32 * ct + ln) ? 1.0f : 0.0f;
                tile_store_T(SLOT(S_T), rt, ct, tm, lane); }
            else { const f32x16 d = mm_tile<1, 0>(SLOT(S_L), rt, SLOT(S_L), ct, zero16(), lane); tile_store_T(SLOT(S_LA), rt, ct, d, lane); }
            __syncthreads();
#pragma unroll
            for (int st = 1; st <= 5; ++st) {
                LAS unsigned char* tin = (st & 1) ? SLOT(S_T) : SLOT(S_TB); LAS unsigned char* tout = (st & 1) ? SLOT(S_TB) : SLOT(S_T);
                LAS unsigned char* lin = (st & 1) ? SLOT(S_LA) : SLOT(S_LB); LAS unsigned char* lout = (st & 1) ? SLOT(S_LB) : SLOT(S_LA);
                if (tw) { tm = mm_tile<1, 0>(tin, rt, lin, ct, tm, lane); tile_store_T(tout, rt, ct, tm, lane); }
                else if (st < 5) { const f32x16 d = mm_tile<1, 0>(lin, rt, lin, ct, zero16(), lane); tile_store_T(lout, rt, ct, d, lane); }
                __syncthreads();
            }
        }
        {
            WL();
            const int mm = w >> 2, rt = (w >> 1) & 1, ct = w & 1;
            const f32x16 d = mm_tile<1, 0>(SLOT(S_TB), rt, mm ? SLOT(S_MBR) : SLOT(S_B), ct, zero16(), lane);
            tile_store_T(mm ? SLOT(S_PH) : SLOT(S_TH), rt, ct, d, lane);
        }
        __syncthreads();
#pragma unroll
        for (int jj = 0; jj < 2; ++jj) {
            WL();
            const int job = 2 * w + jj, mm = job >> 2, rt = (job >> 1) & 1, ct = job & 1;
            if (mm == 0) {
                f32x16 d = mm_tile<0, 0>(SLOT(S_A), rt, SLOT(S_TH), ct, zero16(), lane);
                const int jc = 32 * ct + ln; const float gc = GC[jc];
#pragma unroll
                for (int q4 = 0; q4 < 4; ++q4) { const int j0 = 32 * rt + 8 * q4 + 4 * hl; float x[4];
#pragma unroll
                    for (int e = 0; e < 4; ++e) x[e] = (d[4 * q4 + e] + ((j0 + e == jc) ? 1.0f : 0.0f)) * gc;
                    v2u o; o.x = pk2(x[0], x[1]); o.y = pk2(x[2], x[3]); *(GAS v2u*)(PT + tbo + (size_t)jc * 64 + j0) = o; }
            } else if (mm == 1) {
                const f32x16 d = mm_tile_c<1, 0>(SLOT(S_LAK), rt, SLOT(S_TH), ct, SLOT(S_K), rt, ct, lane);
                tile_store_T(SLOT(S_G2), rt, ct, d, lane);
            } else if (mm == 2) {
                const f32x16 d = mm_tile_c<0, 0>(SLOT(S_PH), rt, SLOT(S_A), ct, SLOT(S_R), rt, ct, lane);
#pragma unroll
                for (int r = 0; r < 16; ++r) RHO[(size_t)(tok0 + 32 * rt + crow32(r, hl)) * 1024 + h * 64 + 32 * ct + ln] = (bf16)f2bf(d[r]);
            } else {
                const f32x16 d = mm_tile_c<1, 0>(SLOT(S_LAK), rt, SLOT(S_PH), ct, SLOT(S_MKR), rt, ct, lane);
                tile_store_T(SLOT(S_OM), rt, ct, d, lane);
            }
        }
        __syncthreads();
        {
            WL();
            const int mm = w >> 2, rt = (w >> 1) & 1, ct = w & 1;
            const f32x16 d = mm_tile<0, 0>(SLOT(S_V), rt, mm ? SLOT(S_OM) : SLOT(S_G2), ct, zero16(), lane);
            if (mm == 0) { const int jc = 32 * ct + ln; const float gc = GC[jc];
#pragma unroll
                for (int q4 = 0; q4 < 4; ++q4) { const int i0 = 32 * rt + 8 * q4 + 4 * hl;
                    v2u o; o.x = pk2(d[4 * q4] * gc, d[4 * q4 + 1] * gc); o.y = pk2(d[4 * q4 + 2] * gc, d[4 * q4 + 3] * gc); *(GAS v2u*)(QT + tbo + (size_t)jc * 64 + i0) = o; }
            } else {
#pragma unroll
                for (int r = 0; r < 16; ++r) ZL[tbo + (size_t)(32 * rt + crow32(r, hl)) * 64 + 32 * ct + ln] = (bf16)f2bf(d[r]);
            }
        }
        __syncthreads();
    }
#undef SLOT
#undef WL
#undef CH_LOAD
}

__device__ __forceinline__ void chain_phase(const Frame& F, const bf16* __restrict__ PT, const bf16* __restrict__ QT, bf16* __restrict__ SB) {
    if ((int)blockIdx.x < BATCH * 16 && F.wave == 0) {
        const int bh = blockIdx.x, lane = ltid() & 63, hl = lane >> 5, ln = lane & 31;
        f32x16 T[2][2];
#pragma unroll
        for (int a = 0; a < 2; ++a)
#pragma unroll
            for (int b = 0; b < 2; ++b) T[a][b] = zero16();
        for (int c = 0; c < NCH; ++c) {
            const size_t tb = ((size_t)bh * NCH + c) * 4096;
            bf16x8 Bf[2][4];
#pragma unroll
            for (int it = 0; it < 2; ++it)
#pragma unroll
                for (int sp = 0; sp < 4; ++sp) { const f32x16& X = T[sp >> 1][it]; const int s = sp & 1; v4u pw;
                    pw.x = pk2(X[8 * s + 0], X[8 * s + 1]); pw.y = pk2(X[8 * s + 2], X[8 * s + 3]); pw.z = pk2(X[8 * s + 4], X[8 * s + 5]); pw.w = pk2(X[8 * s + 6], X[8 * s + 7]);
                    Bf[it][sp] = __builtin_bit_cast(bf16x8, pw);
                    bf16* sp_ = SB + tb + (size_t)(32 * it + ln) * 64 + 16 * sp + 4 * hl;
                    *(GAS v2u*)sp_ = (v2u){pw.x, pw.y}; *(GAS v2u*)(sp_ + 8) = (v2u){pw.z, pw.w}; }
            f32x16 Tn[2][2];
#pragma unroll
            for (int jt = 0; jt < 2; ++jt)
#pragma unroll
                for (int it = 0; it < 2; ++it)
#pragma unroll
                    for (int r = 0; r < 16; ++r) Tn[jt][it][r] = bf2f(QT[tb + (size_t)(32 * jt + crow32(r, hl)) * 64 + 32 * it + ln]);
#pragma unroll
            for (int jt = 0; jt < 2; ++jt)
#pragma unroll
                for (int sp = 0; sp < 4; ++sp) {
                    const bf16* ap = PT + tb + (size_t)(32 * jt + ln) * 64 + 16 * sp + 4 * hl;
                    const v2u a0 = *(const GAS v2u*)ap, a1 = *(const GAS v2u*)(ap + 8);
                    const v4u aw = {a0.x, a0.y, a1.x, a1.y}; const bf16x8 Af = __builtin_bit_cast(bf16x8, aw);
#pragma unroll
                    for (int it = 0; it < 2; ++it) Tn[jt][it] = __builtin_amdgcn_mfma_f32_32x32x16_bf16(Af, Bf[it][sp], Tn[jt][it], 0, 0, 0);
                }
#pragma unroll
            for (int jt = 0; jt < 2; ++jt)
#pragma unroll
                for (int it = 0; it < 2; ++it) T[jt][it] = Tn[jt][it];
        }
    }
}

constexpr int RO_TILE = 17408, RO_P = 65;
__device__ __forceinline__ void rwkv_out_phase(const Frame& F, const bf16* __restrict__ SB, const bf16* __restrict__ RHO, const bf16* __restrict__ ZL, const bf16* __restrict__ Z, const float* __restrict__ BON, const bf16* __restrict__ G,
                                               const float* __restrict__ mu, const float* __restrict__ ln_w, const float* __restrict__ ln_b, bf16* __restrict__ O) {
    const int gw = F.vcu * NWAVES + F.wave, NGW = F.G * NWAVES, lane = ltid() & 63, ln = lane & 31, hl = lane >> 5;
    LAS float* tile = (LAS float*)(F.lds + F.wave * RO_TILE); LAS float* bon = tile + 64 * RO_P;
    for (int task = gw; task < BATCH * 16 * NCH; task += NGW) {
        const int b = task >> 10, h = (task >> 6) & 15, c = task & 63;
        const size_t tbo = (size_t)task * 4096;
        const int tok0 = b * SEQ + c * CH;
        const size_t base = (size_t)tok0 * 1024 + h * 64;
        bon[lane] = BON[(size_t)task * 64 + lane];
        f32x16 acc[2][2];
#pragma unroll
        for (int rt = 0; rt < 2; ++rt)
#pragma unroll
            for (int ct = 0; ct < 2; ++ct)
#pragma unroll
                for (int r = 0; r < 16; ++r) acc[rt][ct][r] = bf2f(ZL[tbo + (size_t)(32 * rt + crow32(r, hl)) * 64 + 32 * ct + ln]);
#pragma unroll
        for (int ks = 0; ks < 4; ++ks) {
            bf16x8 af[2], bfr[2];
#pragma unroll
            for (int rt = 0; rt < 2; ++rt) af[rt] = *(const GAS bf16x8*)(SB + tbo + (size_t)(32 * rt + ln) * 64 + 16 * ks + 8 * hl);
#pragma unroll
            for (int ct = 0; ct < 2; ++ct) bfr[ct] = *(const GAS bf16x8*)(RHO + (size_t)(tok0 + 32 * ct + ln) * 1024 + h * 64 + 16 * ks + 8 * hl);
#pragma unroll
            for (int rt = 0; rt < 2; ++rt)
#pragma unroll
                for (int ct = 0; ct < 2; ++ct) acc[rt][ct] = __builtin_amdgcn_mfma_f32_32x32x16_bf16(af[rt], bfr[ct], acc[rt][ct], 0, 0, 0);
        }
#pragma unroll
        for (int ct = 0; ct < 2; ++ct) {
            float s1 = 0.f;
#pragma unroll
            for (int rt = 0; rt < 2; ++rt)
#pragma unroll
                for (int r = 0; r < 16; ++r) s1 += acc[rt][ct][r];
            s1 += __shfl_xor(s1, 32);
            const float mean = s1 * (1.0f / 64.0f); float s2 = 0.f;
#pragma unroll
            for (int rt = 0; rt < 2; ++rt)
#pragma unroll
                for (int r = 0; r < 16; ++r) { const float d = acc[rt][ct][r] - mean; s2 += d * d; }
            s2 += __shfl_xor(s2, 32);
            const float rstd = 1.0f / sqrtf(s2 * (1.0f / 64.0f) + GN_EPS);
#pragma unroll
            for (int rt = 0; rt < 2; ++rt)
#pragma unroll
                for (int r = 0; r < 16; ++r) tile[(32 * ct + ln) * RO_P + 32 * rt + crow32(r, hl)] = (acc[rt][ct][r] - mean) * rstd;
        }
        LDS_WAIT(); asm volatile("" ::: "memory");
        const float lw = ln_w[h * 64 + lane], lb = ln_b[h * 64 + lane], muv = mu[2048 + h * 64 + lane];
        const bf16* zvp = Z + (size_t)tok0 * NZ + ZC_V + h * 64 + lane;
        float zprev = (c > 0) ? bf2f(*(zvp - NZ)) : 0.f;
#pragma unroll 16
        for (int t = 0; t < CH; ++t) {
            const size_t o = base + (size_t)t * 1024 + lane;
            const float zcur = bf2f(zvp[(size_t)t * NZ]); const float vv = zcur + (zprev - zcur) * muv; zprev = zcur;
            const float yn = tile[t * RO_P + lane], bt = bon[t];
            const float val = (yn * lw + lb + bt * vv) * bf2f(G[o]);
            O[(size_t)(tok0 + t) * KO + 2048 + h * 64 + lane] = (bf16)f2bf(val);
        }
        LDS_WAIT(); asm volatile("" ::: "memory");
    }
}

#ifndef G_FOLD
#define G_FOLD 1
#endif
#ifndef G_FFI
#define G_FFI 1
#endif
#ifndef G_FFO
#define G_FFO 1
#endif
#ifndef G_WIN
#define G_WIN 1
#endif
#ifndef G_LORA
#define G_LORA 1
#endif
#ifndef G_WOUT
#define G_WOUT 1
#endif
#ifndef PH_TOPK
#define PH_TOPK 1
#endif
#ifndef PH_ATTN
#define PH_ATTN 1
#endif
#ifndef PH_SCAN
#define PH_SCAN 1
#endif
#ifndef PH_CHAIN
#define PH_CHAIN 1
#endif
#ifndef PH_ROUT
#define PH_ROUT 1
#endif
#ifndef PH_PREP
#define PH_PREP 1
#endif
#ifndef REPK
#define REPK -1
#endif
#ifndef MK_ONE_LAUNCH
#define MK_ONE_LAUNCH 1
#endif
#ifndef MK_LAST_PHASE
#define MK_LAST_PHASE 31
#endif
constexpr int NPHASE = 31;
#define mod ((float*)(ws + WS_MOD))
#define HN ((bf16*)(ws + WS_HN))
#define Hs ((bf16*)(ws + WS_DEC))
#define ACT ((bf16*)(ws + WS_ACT))
#define Z ((bf16*)(ws + WS_Z))
#define O ((bf16*)(ws + WS_O))
#define CKV ((bf16*)(ws + WS_CKV))
#define IDX ((unsigned short*)(ws + WS_IDX))
#define Rb ((bf16*)(ws + WS_R))
#define Vb ((bf16*)(ws + WS_V))
#define KKb ((bf16*)(ws + WS_KK))
#define Kb ((bf16*)(ws + WS_K))
#define BETAb ((bf16*)(ws + WS_BETA))
#define DECb ((float*)(ws + WS_DEC))
#define LA ((bf16*)(ws + WS_LA))
#define Gb ((bf16*)(ws + WS_G))
#define PT ((bf16*)(ws + WS_PT))
#define ST ((float*)(ws + WS_ST))
#define RHOb ((bf16*)(ws + WS_RHO))
#define SBb ((bf16*)(ws + WS_ST))
#define QT ((bf16*)(ws + WS_QT))
#define ZLOC ((bf16*)(ws + WS_ZLOC))
#define BONb ((float*)(ws + WS_K + 32 * MiB))
#define A1b ((bf16*)(ws + WS_BETA + 32 * MiB))
#define IN(k) (lo <= (k) && (k) < hi)
#define SEAM(k) do { if (IN(k) && IN((k) + 1)) { xcd_barrier(bar); if (REPK == 40) xcd_barrier(bar); } } while (0)
template <int l>
__device__ __forceinline__ void layer_phases(Frame& F, unsigned char* ws, float* out, const int lo, const int hi, const XcdBarrier& bar) {
        const int pb = 2 + 14 * l;
        const float* modl = mod + (size_t)l * BATCH * NMOD;
        const float* ng = KIN(I_NORMG) + (size_t)l * 3 * D;
        if (IN(pb + 0)) { if constexpr (l == 0) adaln_phase(F, KIN(I_X), ng, modl, 0, HN); else adaln_phase_h(F, Hs, ng, modl, 0, HN); }
        SEAM(pb + 0);
#if G_FFI
        if (IN(pb + 1)) { pg8::Gemm g{HN, (const bf16*)(ws + WS_WFI + (size_t)(2 * l) * WFI_ONE), M, NFI, D}; pg8::StaticOrder S; S.init(M, NFI, F.G, (int)blockIdx.x);
            pg8::EpiSwiglu E{ACT, FF}; pg8::gemm_phase<pg8::EpiSwiglu, pg8::StaticOrder, true, true>(F.lds, g, S, E); if (REPK == 1) { __syncthreads(); pg8::gemm_phase<pg8::EpiSwiglu, pg8::StaticOrder, true, true>(F.lds, g, S, E); } }
#endif
        SEAM(pb + 1);
#if G_FFO
        if (IN(pb + 2)) { pg8::Gemm g{ACT, (const bf16*)(ws + WS_WFO + (size_t)(2 * l) * WFO_ONE), M, D, FF}; pg8::StaticOrder S; S.init(M, D, F.G, (int)blockIdx.x, 2);
            pg8::EpiResidH<(l == 0)> E{l == 0 ? (const void*)KIN(I_X) : (const void*)Hs, Hs, D, modl + 2 * D, NMOD, RCOEF(0.5f)}; pg8::gemm_phase<pg8::EpiResidH<(l == 0)>, pg8::StaticOrder, true, true>(F.lds, g, S, E); }
#endif
        SEAM(pb + 2);
        if (IN(pb + 3)) adaln_phase_h(F, Hs, ng + D, modl, 1, HN);
        SEAM(pb + 3);
#if G_WIN
        if (IN(pb + 4)) { pg8::Gemm g{HN, (const bf16*)(ws + WS_WIN + (size_t)l * WIN_ONE), M, NZ, D}; pg8::StaticOrder S; S.init(M, NZ, F.G, (int)blockIdx.x);
            pg8::EpiStoreBf16 E{Z, NZ}; pg8::gemm_phase<pg8::EpiStoreBf16, pg8::StaticOrder, true, true>(F.lds, g, S, E); if (REPK == 4) { __syncthreads(); pg8::gemm_phase<pg8::EpiStoreBf16, pg8::StaticOrder, true, true>(F.lds, g, S, E); } }
#endif
        SEAM(pb + 4);
        if (IN(pb + 5)) {
#if PH_PREP
            prep_phase(F, Z, KIN(I_MU) + (size_t)l * 3520, KIN(I_CKVG) + (size_t)l * 256, LA, CKV); if (REPK == 5) { __syncthreads(); prep_phase(F, Z, KIN(I_MU) + (size_t)l * 3520, KIN(I_CKVG) + (size_t)l * 256, LA, CKV); }
#endif
#if PH_TOPK
            topk_phase<((REPK == 61 || REPK == 63 || REPK == 64 || REPK == 65 || REPK == 66) ? 2 : 1), (REPK == 62 ? 2 : 1)>(F, Z, IDX);
            if (REPK == 6) { __syncthreads(); topk_phase<1, 1>(F, Z, IDX); }
#endif
        }
        SEAM(pb + 5);
        if (IN(pb + 6)) {
#if G_LORA
            { pg8::StaticOrder S; S.init(M, 1024, F.G, (int)blockIdx.x);
              pg8::Gemm g{LA + (size_t)2 * M * 256, (const bf16*)(ws + WS_WLORA + (size_t)(3 * l + 2) * WLORA_ONE), M, 1024, 256};
              pg8::EpiLora<2> E{nullptr, nullptr, nullptr, Gb, nullptr, nullptr, nullptr}; pg8::gemm_phase<pg8::EpiLora<2>, pg8::StaticOrder, true, true>(F.lds, g, S, E); }
            __syncthreads();
#endif
#if PH_SCAN
            chunk_phase<(REPK == 81 ? 2 : 1)>(F, Z, LA, (const bf16*)(ws + WS_WLORA + (size_t)(3 * l) * WLORA_ONE), KIN(I_W0) + (size_t)l * 1024, KIN(I_A0) + (size_t)l * 1024, KIN(I_MU) + (size_t)l * 3520, KIN(I_KK) + (size_t)l * 1024, KIN(I_KA) + (size_t)l * 1024, KIN(I_RK) + (size_t)l * 1024, RHOb, ZLOC, PT, QT, BONb);
#endif
        }
        SEAM(pb + 6);
        if (IN(pb + 8)) {
            attn_setup(F, KIN(I_T5));
#if PH_CHAIN
            chain_phase(F, PT, QT, SBb);
#endif
#if PH_ATTN
            attn_phase(F, Z, CKV, IDX, KIN(I_T5), O, (unsigned*)(F.ctl + CW_WQ + 512 * l));
            if (REPK == 7) attn_phase(F, Z, CKV, IDX, KIN(I_T5), O, (unsigned*)(F.ctl + CW_WQ + 4096 + 512 * l));
#endif
        }
        SEAM(pb + 8);
#if PH_ROUT
        if (IN(pb + 9)) { rwkv_out_phase(F, SBb, RHOb, ZLOC, Z, BONb, Gb, KIN(I_MU) + (size_t)l * 3520, KIN(I_LNW) + (size_t)l * 1024, KIN(I_LNB) + (size_t)l * 1024, O); if (REPK == 10) { __syncthreads(); rwkv_out_phase(F, SBb, RHOb, ZLOC, Z, BONb, Gb, KIN(I_MU) + (size_t)l * 3520, KIN(I_LNW) + (size_t)l * 1024, KIN(I_LNB) + (size_t)l * 1024, O); } }
#endif
        SEAM(pb + 9);
#if G_WOUT
        if (IN(pb + 10)) { pg8::Gemm g{O, (const bf16*)(ws + WS_WOUT + (size_t)l * WOUT_ONE), M, D, KO}; pg8::StaticOrder S; S.init(M, D, F.G, (int)blockIdx.x, 2);
            pg8::EpiResidH<false> E{Hs, Hs, D, modl + (3 + 2) * D, NMOD, RCOEF(1.0f)}; pg8::gemm_phase<pg8::EpiResidH<false>, pg8::StaticOrder, true, true>(F.lds, g, S, E); }
#endif
        SEAM(pb + 10);
        if (IN(pb + 11)) adaln_phase_h(F, Hs, ng + 2 * D, modl, 2, HN);
        SEAM(pb + 11);
#if G_FFI
        if (IN(pb + 12)) { pg8::Gemm g{HN, (const bf16*)(ws + WS_WFI + (size_t)(2 * l + 1) * WFI_ONE), M, NFI, D}; pg8::StaticOrder S; S.init(M, NFI, F.G, (int)blockIdx.x);
            pg8::EpiSwiglu E{ACT, FF}; pg8::gemm_phase<pg8::EpiSwiglu, pg8::StaticOrder, true, true>(F.lds, g, S, E); if (REPK == 1) { __syncthreads(); pg8::gemm_phase<pg8::EpiSwiglu, pg8::StaticOrder, true, true>(F.lds, g, S, E); } }
#endif
        SEAM(pb + 12);
#if G_FFO
        if (IN(pb + 13)) { pg8::Gemm g{ACT, (const bf16*)(ws + WS_WFO + (size_t)(2 * l + 1) * WFO_ONE), M, D, FF}; pg8::StaticOrder S; S.init(M, D, F.G, (int)blockIdx.x, 2);
            pg8::EpiResidH<false> E{Hs, Hs, D, modl + (6 + 2) * D, NMOD, RCOEF(0.5f)}; pg8::gemm_phase<pg8::EpiResidH<false>, pg8::StaticOrder, true, true>(F.lds, g, S, E); }
#endif
        SEAM(pb + 13);
    }

__global__ void __launch_bounds__(NTHR, 2) hybrid_fwd(Params P) {
    extern __shared__ __attribute__((aligned(16))) unsigned char lds_raw[];
    Frame F;
    F.lds = (LAS unsigned char*)lds_raw;
    F.MISC = (volatile LAS unsigned*)(F.lds + MISC_OFF);
    F.wave = __builtin_amdgcn_readfirstlane((int)threadIdx.x >> 6);
    F.G = gridDim.x; { const int bx = blockIdx.x; F.vcu = (F.G % 8 == 0) ? (bx % 8) * (F.G / 8) + bx / 8 : bx; }
    unsigned char* ws = kargs()->ws;
    F.ws = ws; F.ctl = (gu32*)(ws + WS_CTL);
    for (int u = ltid(); u < (LDS_BYTES - LDSCTL_OFF) / 4; u += NTHR) ((LAS unsigned*)(F.lds + LDSCTL_OFF))[u] = 0u;
    __syncthreads();
    const int lo = kargs()->ph_lo, hi = kargs()->ph_hi;
    XcdBarrier bar; bar.bar = (unsigned*)(F.ctl + CW_BAR); bar.x = 0; bar.st = nullptr;
    if (hi - lo > 1) bar = xcd_barrier_post((unsigned*)(F.ctl + CW_BAR), F.MISC + 8);
    float* const out = kargs()->out;

    if (IN(0)) { p0a_prologue(F); if (REPK == 20) { __syncthreads(); p0a_prologue(F); } } SEAM(0);
#if G_FOLD
    if (IN(1)) {
        for (int q = 0; q < 2 * DEPTH; ++q) {
            const int l = q >> 1, which = q & 1;
            const int c = (int)((blockIdx.x + F.G - 64 * q) % F.G);
            pg8::StaticOrder S; S.init(2048, 2048, F.G, c);
            const bf16* Ap = (const bf16*)(ws + (which ? WS_WOUTTA : WS_BDUK) + l * 4 * MiB); const bf16* Bp = (const bf16*)(ws + (which ? WS_BDUV : WS_WINQ) + l * 4 * MiB);
            bf16* Cp = which ? (bf16*)(ws + WS_WOUT + l * WOUT_ONE) : (bf16*)(ws + WS_WIN + l * WIN_ONE);
            pg8::Gemm g{Ap, Bp, 2048, 2048, 1024};
            pg8::EpiStoreBf16 E{Cp, which ? KO : D};
            pg8::gemm_phase<pg8::EpiStoreBf16, pg8::StaticOrder, true, true>(F.lds, g, S, E);
            if (REPK == 21) { __syncthreads(); pg8::gemm_phase<pg8::EpiStoreBf16, pg8::StaticOrder, true, true>(F.lds, g, S, E); }
        }
    }
#endif
    SEAM(1);
    layer_phases<0>(F, ws, out, lo, hi, bar);
    layer_phases<1>(F, ws, out, lo, hi, bar);
    if (IN(30)) final_norm_phase_h(F, Hs, out, KIN(I_FNG));
}

extern "C" void kernel_launch(void* const* d_in, const int* in_sizes, int n_in, void* d_out, int out_size, void* d_ws, size_t ws_size, hipStream_t stream) {
    static int grid = 0;
    if (grid == 0) {
        if (n_in != 25 || in_sizes[0] != M * D || out_size != M * D || ws_size < WS_END) { fprintf(stderr, "kernel_launch: unexpected problem (n_in %d, in0 %d, out %d, ws %zu < %zu)\n", n_in, n_in > 0 ? in_sizes[0] : -1, out_size, ws_size, (size_t)WS_END); grid = -1; return; }
        int dev = 0, cus = 0, per_cu = 0;
        if (hipGetDevice(&dev) != hipSuccess || hipDeviceGetAttribute(&cus, hipDeviceAttributeMultiprocessorCount, dev) != hipSuccess) { grid = -1; return; }
        if (hipFuncSetAttribute((const void*)hybrid_fwd, hipFuncAttributeMaxDynamicSharedMemorySize, LDS_BYTES) != hipSuccess) { fprintf(stderr, "kernel_launch: hipFuncSetAttribute failed\n"); grid = -1; return; }
        if (hipOccupancyMaxActiveBlocksPerMultiprocessor(&per_cu, (const void*)hybrid_fwd, NTHR, LDS_BYTES) != hipSuccess || per_cu < 1) { fprintf(stderr, "kernel_launch: occupancy query reports %d workgroups per CU\n", per_cu); }
        (void)hipGetLastError();
        grid = cus;
    }
    if (grid < 0) return;
    if (hipMemsetAsync((char*)d_ws + WS_CTL, 0, CTL_ZERO_BYTES, stream) != hipSuccess) return;
    Params p{};
    for (int i = 0; i < 25; ++i) p.in[i] = (const float*)d_in[i];
    p.out = (float*)d_out; p.ws = (unsigned char*)d_ws;
#if MK_ONE_LAUNCH
    p.ph_lo = 0; p.ph_hi = MK_LAST_PHASE;
    hipLaunchKernelGGL(hybrid_fwd, dim3(grid), dim3(NTHR), LDS_BYTES, stream, p);
#ifdef PROBE_LO
    if (hipMemsetAsync((char*)d_ws + WS_CTL, 0, CTL_ZERO_BYTES, stream) != hipSuccess) return;
    p.ph_lo = PROBE_LO; p.ph_hi = PROBE_HI; p.rerun = 1;
    hipLaunchKernelGGL(hybrid_fwd, dim3(grid), dim3(NTHR), LDS_BYTES, stream, p);
#endif
#else
    for (int ph = 0; ph < MK_LAST_PHASE; ++ph) { p.ph_lo = ph; p.ph_hi = ph + 1; hipLaunchKernelGGL(hybrid_fwd, dim3(grid), dim3(NTHR), LDS_BYTES, stream, p); }
#endif
}
```
